# Optimizing an MI355X kernel written in HIP

```python
import jax, jax.numpy as jnp
from jax import lax
import numpy as np

D_MODEL = 2048
BATCH = 4
SEQ = 2048
DEPTH = 4

N_MIXERS = 3
N_ATTN_LAYERS = (DEPTH + 2) // 3
N_RWKV_LAYERS = (DEPTH + 1) // 3
N_CONV_LAYERS = DEPTH // 3
PLE_DIM = 256
NORM_EPS = 1e-6
NEG_INF = -1e30

ATTN_GROUPS = ((128, 1), (512, 4), (2048, 16))
N_GROUPS = 3
ATTN_HEADS = 16
ATTN_HEAD_DIM = D_MODEL // ATTN_HEADS
ATTN_BLOCK = 128

RWKV_HEAD_SIZE = 64
RWKV_HEADS = D_MODEL // RWKV_HEAD_SIZE
RWKV_DECAY_LORA = 96
RWKV_A_LORA = 96
RWKV_GATE_LORA = 256
RWKV_GN_EPS = 6.4e-4

CONV_WIDTH = 3

D_FF = 5632
FFN_CONV_WIDTH = 3

kernel_name = "hybrid_dilatedattn_rwkv7_shortconv_convffn"


def rms_norm(x, g):
    xf = x.astype(jnp.float32)
    y = xf * lax.rsqrt(jnp.mean(xf * xf, axis=-1, keepdims=True) + NORM_EPS)
    return (y * g.astype(jnp.float32)).astype(x.dtype)


def causal_dwconv(u, w):
    width = w.shape[0]
    s = u.shape[1]
    up = jnp.pad(u, ((0, 0), (width - 1, 0), (0, 0)))
    y = up[:, 0:s] * w[0]
    for j in range(1, width):
        y = y + up[:, j:j + s] * w[j]
    return y


def alibi_slopes():
    n = N_GROUPS * ATTN_HEADS
    idx = jnp.arange(1, n + 1, dtype=jnp.float32)
    return (2.0 ** (-8.0 * idx / n)).reshape(N_GROUPS, ATTN_HEADS)


def dilated_window_attention(q, k, v, window, dilation, slopes):
    b, s, h, e = q.shape
    n_back = window // dilation
    L = s // dilation
    nb = -(-L // ATTN_BLOCK)
    Lp = nb * ATTN_BLOCK

    def to_blocks(t):
        t = t.reshape(b, L, dilation, h, e)
        t = jnp.pad(t, ((0, 0), (0, Lp - L), (0, 0), (0, 0), (0, 0)))
        return t.reshape(b, nb, ATTN_BLOCK, dilation, h, e)

    def with_prev(t):
        prev = jnp.pad(t, ((0, 0), (1, 0), (0, 0), (0, 0), (0, 0), (0, 0)))[:, :-1]
        return jnp.concatenate([prev, t], axis=2)

    qb = to_blocks(q)
    kw = with_prev(to_blocks(k))
    vw = with_prev(to_blocks(v))

    scale = ATTN_HEAD_DIM ** -0.5
    scores = jnp.einsum('bnqrhe,bnkrhe->bnrhqk', qb, kw,
                        preferred_element_type=jnp.float32) * scale
    qi = jnp.arange(ATTN_BLOCK)[:, None]
    kj = jnp.arange(2 * ATTN_BLOCK)[None, :]
    dist = qi + ATTN_BLOCK - kj
    first = (jnp.arange(nb) == 0)[:, None, None]
    valid = (dist >= 0) & (dist <= n_back) & jnp.logical_not(first & (kj < ATTN_BLOCK))
    bias = -(slopes.astype(jnp.float32)[:, None, None] * (dist * dilation).astype(jnp.float32)[None])
    scores = scores + bias[None, None, None]
    scores = jnp.where(valid[None, :, None, None], scores, NEG_INF)
    m = jnp.max(scores, axis=-1, keepdims=True)
    pr = jnp.exp(scores - m)
    denom = jnp.sum(pr, axis=-1, keepdims=True)
    out = jnp.einsum('bnrhqk,bnkrhe->bnqrhe', (pr / denom).astype(v.dtype), vw)
    lse = (m + jnp.log(denom))[..., 0]
    out = out.reshape(b, Lp, dilation, h, e)[:, :L].reshape(b, s, h, e)
    lse = lse.transpose(0, 1, 4, 2, 3).reshape(b, Lp, dilation, h)[:, :L].reshape(b, s, h)
    return out, lse


def attention_mixer(h, w_qkv, w_o, slopes):
    b, s, _ = h.shape
    qkv = (h @ w_qkv).reshape(b, s, N_GROUPS, 3, ATTN_HEADS, ATTN_HEAD_DIM)
    outs, lses = [], []
    for g, (window, dil) in enumerate(ATTN_GROUPS):
        o, l = dilated_window_attention(qkv[:, :, g, 0], qkv[:, :, g, 1], qkv[:, :, g, 2],
                                        window, dil, slopes[g])
        outs.append(o)
        lses.append(l)
    outs = jnp.stack(outs, 0)
    alpha = jax.nn.softmax(jnp.stack(lses, 0), axis=0)
    o = jnp.sum(alpha[..., None].astype(outs.dtype) * outs, axis=0)
    return o.reshape(b, s, ATTN_HEADS * ATTN_HEAD_DIM) @ w_o


def rwkv7_mixer(h, mu, w_rkv, w0, w_w1, w_w2, a0, w_a1, w_a2, w_g1, w_g2,
                k_k, k_a, r_k, ln_g, ln_b, w_o):
    b, s, d = h.shape
    H, N = RWKV_HEADS, RWKV_HEAD_SIZE
    xx = jnp.pad(h, ((0, 0), (1, 0), (0, 0)))[:, :-1] - h
    x_rkv = h[None] + xx[None] * mu[:3, None, None, :]
    xw = h + xx * mu[3]
    xa = h + xx * mu[4]
    xg = h + xx * mu[5]
    rkv = jnp.einsum('nbsd,nde->nbse', x_rkv, w_rkv)
    r, k, v = rkv[0], rkv[1], rkv[2]
    w_log = -jax.nn.softplus(-(w0 + jnp.tanh(xw @ w_w1) @ w_w2)) - 0.5
    a = jax.nn.sigmoid(a0 + (xa @ w_a1) @ w_a2)
    g = jax.nn.sigmoid(xg @ w_g1) @ w_g2

    kk = (k * k_k).reshape(b, s, H, N).astype(jnp.float32)
    kk = kk / jnp.maximum(jnp.sqrt(jnp.sum(kk * kk, axis=-1, keepdims=True)), 1e-12)
    k = k * (1 + (a - 1) * k_a)
    decay = jnp.exp(-jnp.exp(w_log.astype(jnp.float32)))

    rh = r.reshape(b, s, H, N)
    kh = k.reshape(b, s, H, N)
    vh = v.reshape(b, s, H, N)
    ah = a.reshape(b, s, H, N).astype(jnp.float32)

    def tm(t):
        return jnp.moveaxis(t.astype(jnp.float32), 1, 0)

    seq_in = (tm(rh), tm(decay.reshape(b, s, H, N)), tm(kh), tm(vh), tm(-kk), tm(kk * ah))

    def step(state, inp):
        r_t, w_t, k_t, v_t, a_t, b_t = inp
        sa = jnp.einsum('bhvk,bhk->bhv', state, a_t)
        state = (state * w_t[:, :, None, :] + sa[..., None] * b_t[:, :, None, :]
                 + v_t[..., None] * k_t[:, :, None, :])
        y_t = jnp.einsum('bhvk,bhk->bhv', state, r_t)
        return state, y_t

    state0 = jnp.zeros((b, H, N, N), jnp.float32)
    _, y = lax.scan(step, state0, seq_in)
    y = jnp.moveaxis(y, 0, 1)
    mean = jnp.mean(y, axis=-1, keepdims=True)
    var = jnp.mean(jnp.square(y - mean), axis=-1, keepdims=True)
    y = ((y - mean) * lax.rsqrt(var + RWKV_GN_EPS)).reshape(b, s, d)
    y = (y * ln_g.astype(jnp.float32) + ln_b.astype(jnp.float32)).astype(h.dtype)
    bonus = jnp.sum(rh * kh * r_k, axis=-1, keepdims=True) * vh
    y = y + bonus.reshape(b, s, d)
    return (y * g) @ w_o


def short_conv_mixer(h, w_in, conv_w, w_out):
    bcu = h @ w_in
    gate_b, gate_c, u = jnp.split(bcu, 3, axis=-1)
    y = causal_dwconv(gate_c * u, conv_w)
    return (gate_b * y) @ w_out


def conv_ffn(h, w_gu, conv_w, conv_b, w_down):
    gate, up = jnp.split(h @ w_gu, 2, axis=-1)
    gate = causal_dwconv(gate, conv_w) + conv_b
    return (jax.nn.silu(gate) * up) @ w_down


def setup_inputs(seed: int = 0) -> dict:
    key = jax.random.key(seed)
    ks = iter(jax.random.split(key, 64))
    f32 = jnp.float32
    D, F = D_MODEL, D_FF

    def nrm(shape, scale):
        return jax.random.normal(next(ks), shape, f32) * scale

    def gain(shape):
        return 1.0 + nrm(shape, 0.02)

    nA, nB, nC = N_ATTN_LAYERS, N_RWKV_LAYERS, N_CONV_LAYERS
    inp = {}
    inp['x'] = nrm((BATCH, SEQ, D), 1.0)
    inp['p'] = nrm((DEPTH, BATCH, SEQ, PLE_DIM), 1.0)
    inp['attn_norm'] = gain((nA, D))
    inp['attn_w_qkv'] = nrm((nA, D, N_GROUPS * 3 * ATTN_HEADS * ATTN_HEAD_DIM), D ** -0.5)
    inp['attn_w_o'] = nrm((nA, ATTN_HEADS * ATTN_HEAD_DIM, D), (ATTN_HEADS * ATTN_HEAD_DIM) ** -0.5)
    inp['rwkv_norm'] = gain((nB, D))
    inp['rwkv_mu'] = jax.random.uniform(next(ks), (nB, 6, D), f32)
    inp['rwkv_w_rkv'] = nrm((nB, 3, D, D), D ** -0.5)
    inp['rwkv_w0'] = jax.random.uniform(next(ks), (nB, D), f32, -6.0, -1.0)
    inp['rwkv_w_w1'] = nrm((nB, D, RWKV_DECAY_LORA), D ** -0.5)
    inp['rwkv_w_w2'] = nrm((nB, RWKV_DECAY_LORA, D), RWKV_DECAY_LORA ** -0.5)
    inp['rwkv_a0'] = nrm((nB, D), 0.1)
    inp['rwkv_w_a1'] = nrm((nB, D, RWKV_A_LORA), D ** -0.5)
    inp['rwkv_w_a2'] = nrm((nB, RWKV_A_LORA, D), RWKV_A_LORA ** -0.5)
    inp['rwkv_w_g1'] = nrm((nB, D, RWKV_GATE_LORA), D ** -0.5)
    inp['rwkv_w_g2'] = nrm((nB, RWKV_GATE_LORA, D), RWKV_GATE_LORA ** -0.5)
    inp['rwkv_k_k'] = 0.85 + nrm((nB, D), 0.02)
    inp['rwkv_k_a'] = 1.0 + nrm((nB, D), 0.02)
    inp['rwkv_r_k'] = nrm((nB, RWKV_HEADS, RWKV_HEAD_SIZE), 0.1)
    inp['rwkv_ln_g'] = gain((nB, D))
    inp['rwkv_ln_b'] = nrm((nB, D), 0.01)
    inp['rwkv_w_o'] = nrm((nB, D, D), D ** -0.5)
    inp['conv_norm'] = gain((nC, D))
    inp['conv_w_in'] = nrm((nC, D, 3 * D), D ** -0.5)
    inp['conv_w'] = nrm((nC, CONV_WIDTH, D), CONV_WIDTH ** -0.5)
    inp['conv_w_out'] = nrm((nC, D, D), D ** -0.5)
    inp['ffn_norm'] = gain((DEPTH, D))
    inp['ffn_w_gu'] = nrm((DEPTH, D, 2 * F), D ** -0.5)
    inp['ffn_conv_w'] = nrm((DEPTH, FFN_CONV_WIDTH, F), FFN_CONV_WIDTH ** -0.5)
    inp['ffn_conv_b'] = nrm((DEPTH, F), 0.01)
    inp['ffn_w_down'] = nrm((DEPTH, F, D), F ** -0.5)
    inp['ple_w_proj'] = nrm((DEPTH, PLE_DIM, D), PLE_DIM ** -0.5)
    inp['ple_norm'] = gain((DEPTH, D))
    inp['ple_w_gate'] = nrm((DEPTH, D, D), D ** -0.5)
    inp['final_norm'] = gain((D,))
    return inp


def reference(x, p, attn_norm, attn_w_qkv, attn_w_o,
              rwkv_norm, rwkv_mu, rwkv_w_rkv, rwkv_w0, rwkv_w_w1, rwkv_w_w2,
              rwkv_a0, rwkv_w_a1, rwkv_w_a2, rwkv_w_g1, rwkv_w_g2,
              rwkv_k_k, rwkv_k_a, rwkv_r_k, rwkv_ln_g, rwkv_ln_b, rwkv_w_o,
              conv_norm, conv_w_in, conv_w, conv_w_out,
              ffn_norm, ffn_w_gu, ffn_conv_w, ffn_conv_b, ffn_w_down,
              ple_w_proj, ple_norm, ple_w_gate, final_norm):
    slopes = alibi_slopes()
    for i in range(DEPTH):
        kind, j = i % N_MIXERS, i // N_MIXERS
        if kind == 0:
            h = rms_norm(x, attn_norm[j])
            x = x + attention_mixer(h, attn_w_qkv[j], attn_w_o[j], slopes)
        elif kind == 1:
            h = rms_norm(x, rwkv_norm[j])
            x = x + rwkv7_mixer(h, rwkv_mu[j], rwkv_w_rkv[j], rwkv_w0[j], rwkv_w_w1[j], rwkv_w_w2[j],
                                rwkv_a0[j], rwkv_w_a1[j], rwkv_w_a2[j], rwkv_w_g1[j], rwkv_w_g2[j],
                                rwkv_k_k[j], rwkv_k_a[j], rwkv_r_k[j], rwkv_ln_g[j], rwkv_ln_b[j],
                                rwkv_w_o[j])
        else:
            h = rms_norm(x, conv_norm[j])
            x = x + short_conv_mixer(h, conv_w_in[j], conv_w[j], conv_w_out[j])
        h = rms_norm(x, ffn_norm[i])
        x = x + conv_ffn(h, ffn_w_gu[i], ffn_conv_w[i], ffn_conv_b[i], ffn_w_down[i])
        gate = jax.nn.sigmoid(rms_norm(x, ple_norm[i]) @ ple_w_gate[i])
        x = x + gate * (p[i] @ ple_w_proj[i])
    return rms_norm(x, final_norm)
```

```cpp
#include <hip/hip_runtime.h>
#include <cstdio>
#include <cstdint>
__device__ __forceinline__ int fresh_lane() { int l; asm volatile("v_mbcnt_lo_u32_b32 %0, -1, 0\n\tv_mbcnt_hi_u32_b32 %0, -1, %0" : "=v"(l)); return l; }
#ifndef MK_PER_PHASE
#define MK_PER_PHASE 1
#endif
namespace pg8 {
#define PG8_LAS __attribute__((address_space(3)))
typedef unsigned short bf16_t;
typedef short bf16x8 __attribute__((ext_vector_type(8)));
typedef float f32x4 __attribute__((ext_vector_type(4)));
typedef unsigned u32x4 __attribute__((ext_vector_type(4)));
constexpr int BM = 256, BK = 64, HALF = 128, HTB = HALF * BK * 2  , STAGE_BYTES = 8 * HTB, NXCD = 8, WGM = 8;

__host__ __device__ __forceinline__ int lds_byte(int r, int c) { const int st = (r >> 4) * 2 + (c >> 5), rr = r & 15, cc = c & 31, ob = rr * 64 + cc * 2; return st * 1024 + (ob ^ (((ob >> 9) & 1) << 5)); }
__host__ __device__ __forceinline__ void stage_rc(int b, int& R, int& C) { const int st = b / 1024, sb = b % 1024, swz = sb ^ (((sb >> 9) & 1) << 5); R = (st >> 1) * 16 + swz / 64; C = (st & 1) * 32 + (swz % 64) / 2; }
__host__ __device__ __forceinline__ int perm32(int rho) { const int n = rho >> 4, i = rho & 15; return 8 * (i >> 2) + 4 * n + (i & 3); }

struct Unit { int pm, pn; };
struct Gemm { const bf16_t* A; const bf16_t* Bt; int M, N, K; size_t a_stride; int grp, nsplit;
    __device__ __forceinline__ int asel(int pn) const { return pn < nsplit ? pn / grp : pn - nsplit + nsplit / grp; } };

struct StaticOrder {
    int nM, nN, nwg, G, c;
    __host__ __device__ void init(int M, int N, int G_, int c_) { nM = M / BM; nN = N / BM; nwg = nM * nN; G = G_; c = c_; }
    __host__ __device__ bool next(int i, Unit& u) const {
        const long L = (long)i * G + c; if (L >= nwg) return false;
        int wgid = (int)L; { const int q = nwg / NXCD, r = nwg % NXCD, xcd = wgid % NXCD, off = wgid / NXCD; wgid = (xcd < r ? xcd * (q + 1) : r * (q + 1) + (xcd - r) * q) + off; }
        const int nig = WGM * nN, gid = wgid / nig, fm = gid * WGM, gsz = (nM - fm) < WGM ? (nM - fm) : WGM;
        u.pm = fm + ((wgid % nig) % gsz); u.pn = (wgid % nig) / gsz; return true;
    }
    __device__ __forceinline__ void a_ready(const Unit&) const {}
    __device__ __forceinline__ void done(const Unit&) const {}
};

__device__ __forceinline__ unsigned cvt_pk_bf16(float lo, float hi) { unsigned r; asm volatile("v_cvt_pk_bf16_f32 %0, %1, %2" : "=v"(r) : "v"(lo), "v"(hi)); return r; }
typedef float f32x2 __attribute__((ext_vector_type(2)));
typedef unsigned u32x2 __attribute__((ext_vector_type(2)));
constexpr int DM = 2048;
constexpr int NPART = 32;
__device__ __forceinline__ float bf2f(unsigned short b) { return __uint_as_float(((unsigned)b) << 16); }
__device__ __forceinline__ float fast_sigmoid(float z) { return __builtin_amdgcn_rcpf(1.0f + __expf(-z)); }

__device__ __forceinline__ void rows_rstd(const float* ssq, int row0, int fq, float (&rs)[2][4]) {
#pragma unroll
    for (int ai = 0; ai < 2; ++ai)
#pragma unroll
        for (int m = 0; m < 4; ++m) { const f32x4* p = (const f32x4*)(ssq + (size_t)(row0 + ai * HALF + m * 16) * NPART + fq * 8); const f32x4 a = p[0], b = p[1];
            float s = ((a[0] + a[1]) + (a[2] + a[3])) + ((b[0] + b[1]) + (b[2] + b[3])); s += __shfl_xor(s, 16); s += __shfl_xor(s, 32);
            rs[ai][m] = __builtin_amdgcn_rsqf(s * (1.0f / (float)DM) + 1e-6f); }
}

template <bool SCALE> struct EpiScaleBf16 {
    static constexpr bool PERM = true, AFTER_DRAIN = false;
    bf16_t* O; int ldc; const float* ssq; int split_cols; size_t split_stride;
    __device__ __forceinline__ void operator()(const f32x4 (&acc)[2][2][4][2], const Unit& u, int wr, int wc, int fr, int fq) const {
        const int row0 = u.pm * BM + wr * 64 + fr; int colt = u.pn * BM; bf16_t* base = O;
        if (split_cols) { const int t = colt / split_cols; base += (size_t)t * split_stride; colt -= t * split_cols; }
        const int col0 = colt + wc * 32 + 8 * fq;
        float rs[2][4];
        if (SCALE) rows_rstd(ssq, row0, fq, rs);
#pragma unroll
        for (int ai = 0; ai < 2; ++ai)
#pragma unroll
            for (int m = 0; m < 4; ++m) { bf16_t* rowp = base + (size_t)(row0 + ai * HALF + m * 16) * ldc + col0; const float sc = SCALE ? rs[ai][m] : 1.0f;
#pragma unroll
                for (int bj = 0; bj < 2; ++bj) { const f32x4 v0 = acc[ai][bj][m][0] * sc, v1 = acc[ai][bj][m][1] * sc;
                    u32x4 w; w.x = cvt_pk_bf16(v0[0], v0[1]); w.y = cvt_pk_bf16(v0[2], v0[3]); w.z = cvt_pk_bf16(v1[0], v1[1]); w.w = cvt_pk_bf16(v1[2], v1[3]);
                    *(u32x4*)(rowp + bj * HALF) = w; } }
    }
};

#define EPI_STORE_X(v, o) do { *(f32x4*)(X + (o)) = (v); u32x2 w_; w_.x = cvt_pk_bf16((v)[0], (v)[1]); w_.y = cvt_pk_bf16((v)[2], (v)[3]); *(u32x2*)(XB + (o)) = w_; \
        ss += ((v)[0] * (v)[0] + (v)[1] * (v)[1]) + ((v)[2] * (v)[2] + (v)[3] * (v)[3]); } while (0)

struct EpiResid {
    static constexpr bool PERM = false, AFTER_DRAIN = false;
    const float* base; float* X; bf16_t* XB; float* SSQ;
    __device__ __forceinline__ void operator()(const f32x4 (&acc)[2][2][4][2], const Unit& u, int wr, int wc, int fr, int fq) const {
        const int row0 = u.pm * BM + wr * 64 + fr, col0 = u.pn * BM + wc * 32 + 4 * fq;
#pragma unroll
        for (int ai = 0; ai < 2; ++ai)
#pragma unroll
            for (int m = 0; m < 4; ++m) { const int r = row0 + ai * HALF + m * 16; const size_t off = (size_t)r * DM + col0; float ss = 0.f;
#pragma unroll
                for (int bj = 0; bj < 2; ++bj)
#pragma unroll
                    for (int n = 0; n < 2; ++n) { const size_t o = off + bj * HALF + n * 16; const f32x4 v = *(const f32x4*)(base + o) + acc[ai][bj][m][n]; EPI_STORE_X(v, o); }
                ss += __shfl_xor(ss, 16); ss += __shfl_xor(ss, 32);
                if (fq == 0) SSQ[(size_t)r * NPART + u.pn * 4 + wc] = ss;
                if (m & 1) asm volatile("" ::: "memory"); }
    }
};

struct EpiPle {
    static constexpr bool PERM = false, AFTER_DRAIN = false;
    const float* ssq; const float* base; const bf16_t* PP; float* X; bf16_t* XB; float* SSQ;
    __device__ __forceinline__ void operator()(const f32x4 (&acc)[2][2][4][2], const Unit& u, int wr, int wc, int fr, int fq) const {
        const int row0 = u.pm * BM + wr * 64 + fr, col0 = u.pn * BM + wc * 32 + 4 * fq;
        float rs[2][4]; rows_rstd(ssq, row0, fq, rs);
#pragma unroll
        for (int ai = 0; ai < 2; ++ai)
#pragma unroll
            for (int m = 0; m < 4; ++m) { const int r = row0 + ai * HALF + m * 16; const size_t off = (size_t)r * DM + col0; float ss = 0.f; const float sc = rs[ai][m];
#pragma unroll
                for (int bj = 0; bj < 2; ++bj)
#pragma unroll
                    for (int n = 0; n < 2; ++n) { const size_t o = off + bj * HALF + n * 16; const f32x4 xv = *(const f32x4*)(base + o); const u32x2 pw = *(const u32x2*)(PP + o); const f32x4 a = acc[ai][bj][m][n];
                        f32x4 v; v[0] = xv[0] + fast_sigmoid(a[0] * sc) * __uint_as_float(pw.x << 16); v[1] = xv[1] + fast_sigmoid(a[1] * sc) * __uint_as_float(pw.x & 0xffff0000u);
                        v[2] = xv[2] + fast_sigmoid(a[2] * sc) * __uint_as_float(pw.y << 16); v[3] = xv[3] + fast_sigmoid(a[3] * sc) * __uint_as_float(pw.y & 0xffff0000u);
                        EPI_STORE_X(v, o); }
                ss += __shfl_xor(ss, 16); ss += __shfl_xor(ss, 32);
                if (fq == 0) SSQ[(size_t)r * NPART + u.pn * 4 + wc] = ss;
                if (m & 1) asm volatile("" ::: "memory"); }
    }
};

struct EpiR1 {
    static constexpr bool PERM = false, AFTER_DRAIN = false;
    float* RKV; bf16_t* T1; int M;
    __device__ __forceinline__ void operator()(const f32x4 (&acc)[2][2][4][2], const Unit& u, int wr, int wc, int fr, int fq) const {
        const int row0 = u.pm * BM + wr * 64 + fr, cl0 = wc * 32 + 4 * fq;
        if (u.pn < 24) {
            float* O = RKV + (size_t)(u.pn >> 3) * M * DM + (u.pn & 7) * BM + cl0;
#pragma unroll
            for (int ai = 0; ai < 2; ++ai)
#pragma unroll
                for (int m = 0; m < 4; ++m) { float* rowp = O + (size_t)(row0 + ai * HALF + m * 16) * DM;
#pragma unroll
                    for (int bj = 0; bj < 2; ++bj)
#pragma unroll
                        for (int n = 0; n < 2; ++n) *(f32x4*)(rowp + bj * HALF + n * 16) = acc[ai][bj][m][n]; }
        } else {
            const int mode = u.pn - 24; bf16_t* O = T1 + (size_t)mode * M * 256 + cl0;
#pragma unroll
            for (int ai = 0; ai < 2; ++ai)
#pragma unroll
                for (int m = 0; m < 4; ++m) { bf16_t* rowp = O + (size_t)(row0 + ai * HALF + m * 16) * 256;
#pragma unroll
                    for (int bj = 0; bj < 2; ++bj)
#pragma unroll
                        for (int n = 0; n < 2; ++n) { f32x4 v = acc[ai][bj][m][n];
                            if (mode == 0) {
#pragma unroll
                                for (int j = 0; j < 4; ++j) v[j] = 1.0f - 2.0f * __builtin_amdgcn_rcpf(1.0f + __expf(2.0f * v[j])); }
                            else if (mode == 2) {
#pragma unroll
                                for (int j = 0; j < 4; ++j) v[j] = fast_sigmoid(v[j]); }
                            u32x2 w; w.x = cvt_pk_bf16(v[0], v[1]); w.y = cvt_pk_bf16(v[2], v[3]); *(u32x2*)(rowp + bj * HALF + n * 16) = w; } }
        }
    }
};

struct EpiR2 {
    static constexpr bool PERM = false, AFTER_DRAIN = false;
    float* WAG; const float* w0; const float* a0; int M;
    __device__ __forceinline__ void operator()(const f32x4 (&acc)[2][2][4][2], const Unit& u, int wr, int wc, int fr, int fq) const {
        const int row0 = u.pm * BM + wr * 64 + fr, which = u.pn >> 3, col0 = (u.pn & 7) * BM + wc * 32 + 4 * fq;
        float* O = WAG + (size_t)which * M * DM + col0;
        f32x4 bv[2][2];
#pragma unroll
        for (int bj = 0; bj < 2; ++bj)
#pragma unroll
            for (int n = 0; n < 2; ++n) bv[bj][n] = which == 0 ? *(const f32x4*)(w0 + col0 + bj * HALF + n * 16) : (which == 1 ? *(const f32x4*)(a0 + col0 + bj * HALF + n * 16) : (f32x4){0.f, 0.f, 0.f, 0.f});
#pragma unroll
        for (int ai = 0; ai < 2; ++ai)
#pragma unroll
            for (int m = 0; m < 4; ++m) { float* rowp = O + (size_t)(row0 + ai * HALF + m * 16) * DM;
#pragma unroll
                for (int bj = 0; bj < 2; ++bj)
#pragma unroll
                    for (int n = 0; n < 2; ++n) { f32x4 v = acc[ai][bj][m][n] + bv[bj][n];
                        if (which == 0) {
#pragma unroll
                            for (int j = 0; j < 4; ++j) v[j] = __expf(-0.6065306597126334f * fast_sigmoid(v[j])); }
                        else if (which == 1) {
#pragma unroll
                            for (int j = 0; j < 4; ++j) v[j] = fast_sigmoid(v[j]); }
                        *(f32x4*)(rowp + bj * HALF + n * 16) = v; } }
    }
};

template <class Epi, class Sched, bool ALIGN_EPI = false, bool SP2 = false>
__device__ __forceinline__ void gemm_phase(PG8_LAS unsigned char* lds, const Gemm g, const Sched& S, const Epi& E, const int wid  ) {
    const int lane = fresh_lane(), tid = wid * 64 + lane, wr = wid >> 2, wc = wid & 3, fr = lane & 15, fq = lane >> 4;
    const int K = g.K, nt = K / BK;
    unsigned voffA[2], voffB[2];
#pragma unroll
    for (int i = 0; i < 2; ++i) { int R, C; stage_rc(tid * 16 + i * 8192, R, C); const int Rb = Epi::PERM ? ((R & ~31) + perm32(R & 31)) : R;
        voffA[i] = (unsigned)(R * K + C) * 2u; voffB[i] = (unsigned)(Rb * K + C) * 2u; }
    const size_t kstep = (size_t)(BK * 2);
    const size_t hstep = (size_t)HALF * K * 2;
    const size_t tstep = 2 * hstep;
    const unsigned ldsw = (unsigned)wid * 1024u;
    const int aoff = lds_byte(wr * 64 + fr, fq * 8), boff = lds_byte(wc * 32 + fr, fq * 8);
#define PG8_SA(b, h) (((b) * 2 + (h)) * HTB)
#define PG8_SB(b, h) ((4 + (b) * 2 + (h)) * HTB)
#define PG8_STAGE(bufoff, gbase, voff) do { _Pragma("unroll") for (int _i = 0; _i < 2; ++_i) \
        __builtin_amdgcn_global_load_lds((const unsigned*)((const char*)(gbase) + (voff)[_i]), (PG8_LAS unsigned*)(lds + (bufoff) + ldsw + _i * 8192), 16, 0, 0); } while (0)
#define PG8_LDA(dst, b, h) do { _Pragma("unroll") for (int m = 0; m < 4; ++m) _Pragma("unroll") for (int k = 0; k < 2; ++k) dst[m][k] = *(const PG8_LAS bf16x8*)(lds + PG8_SA(b, h) + aoff + m * 2048 + k * 1024); } while (0)
#define PG8_LDB(dst, b, h) do { _Pragma("unroll") for (int n = 0; n < 2; ++n) _Pragma("unroll") for (int k = 0; k < 2; ++k) dst[n][k] = *(const PG8_LAS bf16x8*)(lds + PG8_SB(b, h) + boff + n * 2048 + k * 1024); } while (0)
#define PG8_MMA(ai, bj, At, Bt) do { __builtin_amdgcn_s_setprio(1); _Pragma("unroll") for (int m = 0; m < 4; ++m) _Pragma("unroll") for (int n = 0; n < 2; ++n) _Pragma("unroll") for (int k = 0; k < 2; ++k) \
        acc[ai][bj][m][n] = __builtin_amdgcn_mfma_f32_16x16x32_bf16(Bt[n][k], At[m][k], acc[ai][bj][m][n], 0, 0, 0); __builtin_amdgcn_s_setprio(0); } while (0)
#define PG8_WAIT_V(n) asm volatile("s_waitcnt vmcnt(" #n ")" ::: "memory")
#define PG8_WAIT_L(n) asm volatile("s_waitcnt lgkmcnt(" #n ")" ::: "memory")
#define PG8_BAR __builtin_amdgcn_s_barrier()
#define PG8_SCHED __builtin_amdgcn_sched_barrier(0)
    Unit cur, nxt; int ui = 0;
    if (!S.next(0, cur)) return;
    f32x4 acc[2][2][4][2];
#pragma unroll
    for (int a = 0; a < 2; ++a)
#pragma unroll
        for (int b = 0; b < 2; ++b)
#pragma unroll
            for (int m = 0; m < 4; ++m)
#pragma unroll
                for (int n = 0; n < 2; ++n) acc[a][b][m][n] = (f32x4){0.f, 0.f, 0.f, 0.f};
    bf16x8 At[4][2], B0[2][2], B1[2][2];
    const char* cA = (const char*)g.A + (size_t)g.asel(cur.pn) * g.a_stride + (size_t)cur.pm * tstep; const char* cB = (const char*)g.Bt + (size_t)cur.pn * tstep;
    S.a_ready(cur);
    if constexpr (SP2) {
        PG8_STAGE(PG8_SB(0, 0), cB, voffB); PG8_STAGE(PG8_SB(0, 1), cB + hstep, voffB); PG8_STAGE(PG8_SA(0, 0), cA, voffA); PG8_STAGE(PG8_SA(0, 1), cA + hstep, voffA);
        if (wr == 1) PG8_BAR;
        PG8_WAIT_V(2); PG8_BAR;
        PG8_STAGE(PG8_SB(1, 0), cB + kstep, voffB); PG8_STAGE(PG8_SA(1, 0), cA + kstep, voffA); PG8_STAGE(PG8_SB(1, 1), cB + hstep + kstep, voffB);
        PG8_WAIT_V(6); PG8_BAR;
    } else {
        PG8_STAGE(PG8_SB(0, 0), cB, voffB); PG8_STAGE(PG8_SA(0, 0), cA, voffA); PG8_STAGE(PG8_SB(0, 1), cB + hstep, voffB); PG8_STAGE(PG8_SA(0, 1), cA + hstep, voffA);
        if (wr == 1) PG8_BAR;
        PG8_WAIT_V(4); PG8_BAR;
        PG8_STAGE(PG8_SB(1, 0), cB + kstep, voffB); PG8_STAGE(PG8_SA(1, 0), cA + kstep, voffA); PG8_STAGE(PG8_SB(1, 1), cB + hstep + kstep, voffB);
        PG8_WAIT_V(6); PG8_BAR;
    }
    for (;;) {
        const bool has_next = S.next(ui + 1, nxt);
        const char* nA = has_next ? (const char*)g.A + (size_t)g.asel(nxt.pn) * g.a_stride + (size_t)nxt.pm * tstep : cA; const char* nB = has_next ? (const char*)g.Bt + (size_t)nxt.pn * tstep : cB;
        for (int t = 0; t < nt; t += 2) {
            const bool last = (t == nt - 2);
            const char* a1 = cA + (size_t)(t + 1) * kstep;
            const char* a2 = last ? nA : cA + (size_t)(t + 2) * kstep; const char* b2 = last ? nB : cB + (size_t)(t + 2) * kstep;
            const char* a3 = a2 + kstep; const char* b3 = b2 + kstep;
            if (last && has_next) S.a_ready(nxt);
            if constexpr (SP2) {
            PG8_LDB(B0, 0, 0); PG8_LDB(B1, 0, 1); PG8_SCHED; PG8_LDA(At, 0, 0); PG8_STAGE(PG8_SA(1, 1), a1 + hstep, voffA);
            PG8_WAIT_V(8); PG8_WAIT_L(0); PG8_BAR; PG8_MMA(0, 0, At, B0); PG8_MMA(0, 1, At, B1); PG8_BAR; PG8_SCHED;
            PG8_LDA(At, 0, 1); PG8_STAGE(PG8_SB(0, 0), b2, voffB); PG8_STAGE(PG8_SB(0, 1), b2 + hstep, voffB); PG8_STAGE(PG8_SA(0, 0), a2, voffA);
            PG8_WAIT_V(8); PG8_WAIT_L(0); PG8_BAR; PG8_MMA(1, 0, At, B0); PG8_MMA(1, 1, At, B1); PG8_BAR; PG8_SCHED;
            PG8_LDB(B0, 1, 0); PG8_LDB(B1, 1, 1); PG8_SCHED; PG8_LDA(At, 1, 0); PG8_STAGE(PG8_SA(0, 1), a2 + hstep, voffA);
            PG8_WAIT_V(8); PG8_WAIT_L(0); PG8_BAR; PG8_MMA(0, 0, At, B0); PG8_MMA(0, 1, At, B1); PG8_BAR; PG8_SCHED;
            PG8_LDA(At, 1, 1); PG8_STAGE(PG8_SB(1, 0), b3, voffB); PG8_STAGE(PG8_SB(1, 1), b3 + hstep, voffB); PG8_STAGE(PG8_SA(1, 0), a3, voffA);
            PG8_WAIT_V(8); PG8_WAIT_L(0); PG8_BAR; PG8_MMA(1, 0, At, B0); PG8_MMA(1, 1, At, B1); PG8_BAR; PG8_SCHED;
            } else {
            PG8_LDB(B0, 0, 0); PG8_SCHED; PG8_LDA(At, 0, 0); PG8_STAGE(PG8_SA(1, 1), a1 + hstep, voffA);
            PG8_WAIT_L(8); PG8_BAR; PG8_WAIT_L(0); PG8_MMA(0, 0, At, B0); PG8_BAR; PG8_SCHED;
            PG8_LDB(B1, 0, 1); PG8_STAGE(PG8_SB(0, 0), b2, voffB);
            PG8_BAR; PG8_WAIT_L(0); PG8_MMA(0, 1, At, B1); PG8_BAR;
            PG8_LDA(At, 0, 1); PG8_STAGE(PG8_SA(0, 0), a2, voffA);
            PG8_BAR; PG8_WAIT_L(0); PG8_MMA(1, 0, At, B0); PG8_BAR; PG8_SCHED;
            PG8_STAGE(PG8_SB(0, 1), b2 + hstep, voffB);
            PG8_WAIT_V(6); PG8_BAR; PG8_MMA(1, 1, At, B1); PG8_BAR;
            PG8_LDB(B0, 1, 0); PG8_SCHED; PG8_LDA(At, 1, 0); PG8_STAGE(PG8_SA(0, 1), a2 + hstep, voffA);
            PG8_WAIT_L(8); PG8_BAR; PG8_WAIT_L(0); PG8_MMA(0, 0, At, B0); PG8_BAR; PG8_SCHED;
            PG8_LDB(B1, 1, 1); PG8_STAGE(PG8_SB(1, 0), b3, voffB);
            PG8_BAR; PG8_WAIT_L(0); PG8_MMA(0, 1, At, B1); PG8_BAR;
            PG8_LDA(At, 1, 1); PG8_STAGE(PG8_SA(1, 0), a3, voffA);
            PG8_BAR; PG8_WAIT_L(0); PG8_MMA(1, 0, At, B0); PG8_BAR; PG8_SCHED;
            PG8_STAGE(PG8_SB(1, 1), b3 + hstep, voffB);
            PG8_WAIT_V(6); PG8_BAR; PG8_MMA(1, 1, At, B1); PG8_BAR;
            }
        }
        if constexpr (ALIGN_EPI) { if (wr == 0) PG8_BAR; }
        if constexpr (!Epi::AFTER_DRAIN) { const int l2 = fresh_lane(); E(acc, cur, wr, wc, l2 & 15, l2 >> 4); S.done(cur); }
        if (!has_next) break;
#pragma unroll
        for (int a = 0; a < 2; ++a)
#pragma unroll
            for (int b = 0; b < 2; ++b)
#pragma unroll
                for (int m = 0; m < 4; ++m)
#pragma unroll
                    for (int n = 0; n < 2; ++n) acc[a][b][m][n] = (f32x4){0.f, 0.f, 0.f, 0.f};
        cur = nxt; cA = nA; cB = nB; ++ui;
        if constexpr (ALIGN_EPI) { if (wr == 1) PG8_BAR; }
    }
    PG8_WAIT_V(0);
    if constexpr (!ALIGN_EPI) { if (wr == 0) PG8_BAR; }
    PG8_BAR;
    if constexpr (Epi::AFTER_DRAIN) { E.fused(acc, cur, wr, wc, fr, fq, lds, wid, lane); S.done(cur); }
#undef PG8_SA
#undef PG8_SB
#undef PG8_STAGE
#undef PG8_LDA
#undef PG8_LDB
#undef PG8_MMA
#undef PG8_WAIT_V
#undef PG8_WAIT_L
#undef PG8_BAR
#undef PG8_SCHED
}
}

constexpr int NB = 4, SEQ = 2048, D = 2048, M = NB * SEQ, DEPTH = 4, PLE = 256, FF = 5632, NQKV = 18432;
constexpr int NWAVES = 8, NTHR = 512;
constexpr size_t MiB = 1ull << 20;
constexpr size_t WS_CTL = 0, CTL_ZERO_BYTES = 1 * MiB;
constexpr size_t WS_WQKV = 1 * MiB;
constexpr size_t WS_WAO = 145 * MiB;
constexpr size_t WS_WR1 = 161 * MiB;
constexpr size_t WS_WR2 = 188 * MiB;
constexpr size_t WS_WRO = 191 * MiB;
constexpr size_t WS_WCIN = 199 * MiB;
constexpr size_t WS_WCOUT = 223 * MiB;
constexpr size_t WS_WGU = 231 * MiB;
constexpr size_t WS_WDN = 407 * MiB;
constexpr size_t WS_WPG = 495 * MiB;
constexpr size_t WS_WPP = 527 * MiB;
constexpr size_t WS_XB = 531 * MiB;
constexpr size_t WS_SSQ = 595 * MiB;
constexpr size_t WS_PB = 597 * MiB;
constexpr size_t WS_PPO = 613 * MiB;
constexpr size_t WS_MO = 741 * MiB;
constexpr size_t WS_SCR = 773 * MiB;
constexpr size_t WS_END = 1233 * MiB;
constexpr size_t SC_QKV = 0, SC_O12 = 288 * MiB, SC_LSE = 352 * MiB;
constexpr size_t SC_GU = 0, SC_ACT = 176 * MiB;
constexpr size_t SC_MIX = 0, SC_WAG = 0, SC_RKV = 192 * MiB, SC_T1 = 384 * MiB, SC_Y = 396 * MiB;
constexpr size_t SC_BCU = 0;
constexpr int CW_BAR = 4096;

constexpr int RING_BYTES = 131072, MISC_OFF = RING_BYTES + 320, LDS_BYTES = 147456;

#define GAS __attribute__((address_space(1)))
#define LAS __attribute__((address_space(3)))
typedef unsigned short bf16;
typedef unsigned v4u __attribute__((ext_vector_type(4)));
typedef unsigned v2u __attribute__((ext_vector_type(2)));
typedef float f32x4 __attribute__((ext_vector_type(4)));
typedef float f32x16 __attribute__((ext_vector_type(16)));
typedef short bf16x8 __attribute__((ext_vector_type(8)));
typedef short s16x4 __attribute__((ext_vector_type(4)));
#define LDS_WAIT() asm volatile("s_waitcnt lgkmcnt(0)" ::: "memory")
__device__ __forceinline__ unsigned f2bf(float f) { unsigned u = __builtin_bit_cast(unsigned, f); return (u + 0x7fffu + ((u >> 16) & 1u)) >> 16; }
__device__ __forceinline__ unsigned pk2(float lo, float hi) { return f2bf(lo) | (f2bf(hi) << 16); }
__device__ __forceinline__ float bfl(unsigned w) { return __uint_as_float(w << 16); }
__device__ __forceinline__ float bfh(unsigned w) { return __uint_as_float(w & 0xffff0000u); }
__device__ __forceinline__ float wave_sum(float v) {
#pragma unroll
    for (int o = 1; o < 64; o <<= 1) v += __shfl_xor(v, o);
    return v;
}
template <int CTRL> __device__ __forceinline__ float dpp_f(float x) { return __int_as_float(__builtin_amdgcn_update_dpp(0, __float_as_int(x), CTRL, 0xF, 0xF, true)); }
__device__ __forceinline__ float red8(float x) { x += dpp_f<0xB1>(x); x += dpp_f<0x4E>(x); x += dpp_f<0x141>(x); return x; }
__device__ __forceinline__ float red16(float x) { x = red8(x); x += dpp_f<0x140>(x); return x; }

#define XB_TMO      128
#define XB_XCNT(j)  (256  + 64 * (j))
#define XB_XSUB(j)  (1280 + 64 * (j))
#define XB_XGEN(j)  (2304 + 64 * (j))
#define XB_TOP      3328
#define XB_TOPGEN   3392
#define XCD_BAR_WORDS 3456
#define XB_SPIN_CAP (1u << 18)

__device__ __forceinline__ unsigned xb_ld(unsigned* p)              { return __hip_atomic_load(p, __ATOMIC_RELAXED, __HIP_MEMORY_SCOPE_AGENT); }
__device__ __forceinline__ unsigned xb_add(unsigned* p, unsigned v) { return __hip_atomic_fetch_add(p, v, __ATOMIC_RELAXED, __HIP_MEMORY_SCOPE_AGENT); }
__device__ __forceinline__ unsigned xb_xcc_id() { return (unsigned)__builtin_amdgcn_s_getreg((3 << 11) | 20) & 0xFu; }
#define XB_SPIN(cond, bar) do { unsigned _sp = 0; while (cond) { __builtin_amdgcn_s_sleep(1); \
    if ((++_sp & 255u) == 0u) { if (xb_ld(&(bar)[XB_TMO])) break; if (_sp > XB_SPIN_CAP) { atomicAdd(&(bar)[XB_TMO], 1u); break; } } } } while (0)

struct XcdBarrier {
    unsigned* bar; unsigned x;
    volatile LAS unsigned* st;
};

__device__ __forceinline__ XcdBarrier xcd_barrier_post(unsigned* bar, volatile LAS unsigned* st) {
    XcdBarrier b; b.bar = bar; b.x = xb_xcc_id(); b.st = st;
    if (threadIdx.x == 0) (void)xb_add(&bar[XB_XCNT(b.x)], 1u);
    return b;
}
__device__ __forceinline__ void xcd_barrier_complete(unsigned* bar, unsigned x, unsigned& nloc, unsigned& nx) {
    const unsigned G = gridDim.x * gridDim.y * gridDim.z;
    unsigned sum, cnt, mine, sp = 0u;
    for (;;) {
        sum = 0u; cnt = 0u; mine = 0u;
#pragma unroll
        for (unsigned j = 0; j < 16; ++j) { const unsigned c = xb_ld(&bar[XB_XCNT(j)]); sum += c; cnt += (c > 0u) ? 1u : 0u; mine = (j == x) ? c : mine; }
        if (sum == G) break;
        __builtin_amdgcn_s_sleep(1);
        if ((++sp & 255u) == 0u) { if (xb_ld(&bar[XB_TMO])) break; if (sp > XB_SPIN_CAP) { atomicAdd(&bar[XB_TMO], 1u); break; } }
    }
    nloc = mine > 0u ? mine : 1u; nx = cnt > 0u ? cnt : 1u;
}

__device__ __forceinline__ void xcd_barrier(const XcdBarrier& b) {
    asm volatile("s_waitcnt vmcnt(0)" ::: "memory");
    __syncthreads();
    if (threadIdx.x == 0) {
        unsigned* bar = b.bar;
        __builtin_amdgcn_s_waitcnt(0);
        unsigned nloc = b.st[0], nx = b.st[1];
        if (nloc == 0u) { xcd_barrier_complete(bar, b.x, nloc, nx); b.st[0] = nloc; b.st[1] = nx; }
        const unsigned old = xb_add(&bar[XB_XSUB(b.x)], 1u);
        const unsigned gen = old / nloc;
        if (old + 1u == (gen + 1u) * nloc) {
            __builtin_amdgcn_fence(__ATOMIC_RELEASE, "agent");
            asm volatile("s_waitcnt vmcnt(0)" ::: "memory");
            const unsigned og = xb_add(&bar[XB_TOP], 1u);
            const unsigned tg = og / nx;
            if (og + 1u == (tg + 1u) * nx) xb_add(&bar[XB_TOPGEN], 1u);
            else XB_SPIN(xb_ld(&bar[XB_TOPGEN]) == tg, bar);
            __builtin_amdgcn_fence(__ATOMIC_ACQUIRE, "agent");
            xb_add(&bar[XB_XGEN(b.x)], 1u);
            asm volatile("s_waitcnt vmcnt(0)" ::: "memory");
        } else {
            XB_SPIN(xb_ld(&bar[XB_XGEN(b.x)]) == gen, bar);
            __builtin_amdgcn_fence(__ATOMIC_ACQUIRE, "agent");
            asm volatile("s_waitcnt vmcnt(0)" ::: "memory");
        }
    }
    __syncthreads();
}


struct Params { const float* in[35]; float* out; unsigned char* wsp; int lo, hi; };
struct Frame {
    LAS unsigned char* lds;
    int tid, lane;
    int wave;
    int vcu, G;
    __device__ __forceinline__ void ids() { lane = fresh_lane(); tid = wave * 64 + lane; }
};
constexpr int PTR_OFF = RING_BYTES + 1024;
__device__ __forceinline__ const float* in_ptr(const Frame& F, int idx) {
    const LAS unsigned* p = (const LAS unsigned*)(F.lds + PTR_OFF) + 2 * idx; const unsigned lo = __builtin_amdgcn_readfirstlane(p[0]), hi = __builtin_amdgcn_readfirstlane(p[1]);
    return (const float*)(const GAS float*)(size_t)(((unsigned long long)hi << 32) | lo); }
#define T_OUT 35
#define T_WS 36
enum { I_X = 0, I_P, I_ATTN_NORM, I_ATTN_WQKV, I_ATTN_WO, I_RWKV_NORM, I_RWKV_MU, I_RWKV_WRKV, I_RWKV_W0, I_RWKV_WW1, I_RWKV_WW2, I_RWKV_A0, I_RWKV_WA1, I_RWKV_WA2, I_RWKV_WG1, I_RWKV_WG2,
       I_RWKV_KK, I_RWKV_KA, I_RWKV_RK, I_RWKV_LNG, I_RWKV_LNB, I_RWKV_WO, I_CONV_NORM, I_CONV_WIN, I_CONV_W, I_CONV_WOUT, I_FFN_NORM, I_FFN_WGU, I_FFN_CONVW, I_FFN_CONVB, I_FFN_WDOWN,
       I_PLE_WPROJ, I_PLE_NORM, I_PLE_WGATE, I_FINAL_NORM };

struct MatI { int in_idx; long long src_off; int gain_idx; int gain_off; long long dst_off; int K, N, Kp, Np; };
#define MAT(ii, so, gi, go, dof, K_, N_, Kp_, Np_) { ii, (long long)(so), gi, go, (long long)(dof), K_, N_, Kp_, Np_ }
__device__ const MatI kMats[] = {
    MAT(I_ATTN_WQKV, 0, I_ATTN_NORM, 0, WS_WQKV, D, NQKV, D, NQKV),
    MAT(I_ATTN_WQKV, (long long)D * NQKV, I_ATTN_NORM, D, WS_WQKV + 72 * MiB, D, NQKV, D, NQKV),
    MAT(I_ATTN_WO, 0, -1, 0, WS_WAO, D, D, D, D),
    MAT(I_ATTN_WO, (long long)D * D, -1, 0, WS_WAO + 8 * MiB, D, D, D, D),
    MAT(I_RWKV_WRKV, 0, -1, 0, WS_WR1, D, D, D, D),
    MAT(I_RWKV_WRKV, (long long)D * D, -1, 0, WS_WR1 + (size_t)2048 * D * 2, D, D, D, D),
    MAT(I_RWKV_WRKV, 2ll * D * D, -1, 0, WS_WR1 + (size_t)4096 * D * 2, D, D, D, D),
    MAT(I_RWKV_WW1, 0, -1, 0, WS_WR1 + (size_t)6144 * D * 2, D, 96, D, 256),
    MAT(I_RWKV_WA1, 0, -1, 0, WS_WR1 + (size_t)6400 * D * 2, D, 96, D, 256),
    MAT(I_RWKV_WG1, 0, -1, 0, WS_WR1 + (size_t)6656 * D * 2, D, 256, D, 256),
    MAT(I_RWKV_WW2, 0, -1, 0, WS_WR2, 96, D, 256, D),
    MAT(I_RWKV_WA2, 0, -1, 0, WS_WR2 + (size_t)2048 * 256 * 2, 96, D, 256, D),
    MAT(I_RWKV_WG2, 0, -1, 0, WS_WR2 + (size_t)4096 * 256 * 2, 256, D, 256, D),
    MAT(I_RWKV_WO, 0, -1, 0, WS_WRO, D, D, D, D),
    MAT(I_CONV_WIN, 0, I_CONV_NORM, 0, WS_WCIN, D, 3 * D, D, 3 * D),
    MAT(I_CONV_WOUT, 0, -1, 0, WS_WCOUT, D, D, D, D),
    MAT(I_FFN_WGU, 0ll * D * 2 * FF, I_FFN_NORM, 0 * D, WS_WGU + 0 * 44 * MiB, D, 2 * FF, D, 2 * FF),
    MAT(I_FFN_WGU, 1ll * D * 2 * FF, I_FFN_NORM, 1 * D, WS_WGU + 1 * 44 * MiB, D, 2 * FF, D, 2 * FF),
    MAT(I_FFN_WGU, 2ll * D * 2 * FF, I_FFN_NORM, 2 * D, WS_WGU + 2 * 44 * MiB, D, 2 * FF, D, 2 * FF),
    MAT(I_FFN_WGU, 3ll * D * 2 * FF, I_FFN_NORM, 3 * D, WS_WGU + 3 * 44 * MiB, D, 2 * FF, D, 2 * FF),
    MAT(I_FFN_WDOWN, 0ll * FF * D, -1, 0, WS_WDN + 0 * 22 * MiB, FF, D, FF, D),
    MAT(I_FFN_WDOWN, 1ll * FF * D, -1, 0, WS_WDN + 1 * 22 * MiB, FF, D, FF, D),
    MAT(I_FFN_WDOWN, 2ll * FF * D, -1, 0, WS_WDN + 2 * 22 * MiB, FF, D, FF, D),
    MAT(I_FFN_WDOWN, 3ll * FF * D, -1, 0, WS_WDN + 3 * 22 * MiB, FF, D, FF, D),
    MAT(I_PLE_WGATE, 0ll * D * D, I_PLE_NORM, 0 * D, WS_WPG + 0 * 8 * MiB, D, D, D, D),
    MAT(I_PLE_WGATE, 1ll * D * D, I_PLE_NORM, 1 * D, WS_WPG + 1 * 8 * MiB, D, D, D, D),
    MAT(I_PLE_WGATE, 2ll * D * D, I_PLE_NORM, 2 * D, WS_WPG + 2 * 8 * MiB, D, D, D, D),
    MAT(I_PLE_WGATE, 3ll * D * D, I_PLE_NORM, 3 * D, WS_WPG + 3 * 8 * MiB, D, D, D, D),
    MAT(I_PLE_WPROJ, 0ll * PLE * D, -1, 0, WS_WPP + 0 * MiB, PLE, D, PLE, D),
    MAT(I_PLE_WPROJ, 1ll * PLE * D, -1, 0, WS_WPP + 1 * MiB, PLE, D, PLE, D),
    MAT(I_PLE_WPROJ, 2ll * PLE * D, -1, 0, WS_WPP + 2 * MiB, PLE, D, PLE, D),
    MAT(I_PLE_WPROJ, 3ll * PLE * D, -1, 0, WS_WPP + 3 * MiB, PLE, D, PLE, D),
};
constexpr int NMAT = sizeof(kMats) / sizeof(kMats[0]);

__device__ __forceinline__ void conv_item(const float* W, const float* gain, int K, int N, int Kp, int Np, bf16* WT, LAS float* scr, int item, int lane) {
    const int nblk = Np / 32, kb = item / nblk, nb = item % nblk, k0 = 64 * kb, n0 = 32 * nb;
    const int n = n0 + (lane & 31);
#pragma unroll 8
    for (int i = 0; i < 32; ++i) { const int kk = 2 * i + (lane >> 5), k = k0 + kk; float v = 0.f;
        if (k < K && n < N) { v = W[(size_t)k * N + n]; if (gain) v *= gain[k]; }
        scr[kk * 33 + (lane & 31)] = v; }
    LDS_WAIT(); asm volatile("" ::: "memory");
    const int c = lane & 7;
#pragma unroll
    for (int j = 0; j < 4; ++j) { const int nn = (lane >> 3) + 8 * j; const LAS float* s = scr + (8 * c) * 33 + nn;
        v4u o; o.x = pk2(s[0 * 33], s[1 * 33]); o.y = pk2(s[2 * 33], s[3 * 33]); o.z = pk2(s[4 * 33], s[5 * 33]); o.w = pk2(s[6 * 33], s[7 * 33]);
        *(GAS v4u*)(WT + (size_t)(n0 + nn) * Kp + k0 + 8 * c) = o; }
    LDS_WAIT(); asm volatile("" ::: "memory");
}

__device__ __forceinline__ void p_prologue(Frame& F) {
    F.ids();
    unsigned char* const ws_ = (unsigned char*)in_ptr(F, T_WS);
    LAS float* scr = (LAS float*)(F.lds + F.wave * 16384);
    const int gw = F.vcu * NWAVES + F.wave, NGW = F.G * NWAVES;
    int it = gw, base = 0;
    for (int mi = 0; mi < NMAT; ++mi) {
        const MatI mt = kMats[mi]; const int cnt = (mt.Kp / 64) * (mt.Np / 32);
        const float* src = in_ptr(F, mt.in_idx) + mt.src_off; const float* gain = mt.gain_idx >= 0 ? in_ptr(F, mt.gain_idx) + mt.gain_off : nullptr; bf16* dst = (bf16*)(ws_ + mt.dst_off);
        while (it < base + cnt) { conv_item(src, gain, mt.K, mt.N, mt.Kp, mt.Np, dst, scr, it - base, F.lane); it += NGW; }
        base += cnt;
    }
    const float* x = in_ptr(F, I_X); bf16* xb = (bf16*)(ws_ + WS_XB); float* ssq = (float*)(ws_ + WS_SSQ);
    for (int m = gw; m < M; m += NGW) {
        const GAS f32x4* xr = (const GAS f32x4*)(x + (size_t)m * D) + F.lane; GAS v2u* o8 = (GAS v2u*)(xb + (size_t)m * D) + F.lane; float s = 0.f;
#pragma unroll
        for (int j = 0; j < 8; ++j) { const f32x4 v = xr[64 * j]; s += (v[0] * v[0] + v[1] * v[1]) + (v[2] * v[2] + v[3] * v[3]); v2u w; w.x = pk2(v[0], v[1]); w.y = pk2(v[2], v[3]); o8[64 * j] = w; }
        s = wave_sum(s);
        if (F.lane < 32) ssq[(size_t)m * 32 + F.lane] = F.lane == 0 ? s : 0.f;
    }
    const GAS f32x4* p4 = (const GAS f32x4*)in_ptr(F, I_P); GAS v2u* pb = (GAS v2u*)(ws_ + WS_PB);
    for (size_t i = (size_t)F.vcu * NTHR + F.tid; i < (size_t)DEPTH * M * PLE / 4; i += (size_t)F.G * NTHR) { const f32x4 v = p4[i]; v2u w; w.x = pk2(v[0], v[1]); w.y = pk2(v[2], v[3]); pb[i] = w; }
}

__device__ __forceinline__ int tokrow(int b, int v, int Lsh) { return b * SEQ + ((v & ((1 << Lsh) - 1)) << (11 - Lsh)) + (v >> Lsh); }
template <int OFF> __device__ __forceinline__ s16x4 tr_read(unsigned a) { s16x4 r; asm volatile("ds_read_b64_tr_b16 %0, %1 offset:%2" : "=&v"(r) : "v"(a), "i"(OFF) : "memory"); return r; }
constexpr int VROW = 320;

template <bool COMBINE>
__device__ __forceinline__ void attn_phase(Frame& F, const bf16* QKV, bf16* O12, float* LSE, bf16* MO) {
    F.ids();
    const unsigned ldsb = (unsigned)(size_t)F.lds;
    const int nunits = COMBINE ? NB * 16 * 8 : NB * 2 * 16 * 8;
    for (int u = F.vcu; u < nunits; u += F.G) {
        F.ids();
        const int lane = F.lane, ql = lane & 31, hh = lane >> 5;
        const int qblk = u & 7, h = (u >> 3) & 15, rest = u >> 7;
        const int gg = COMBINE ? 0 : 1 + (rest & 1), b = COMBINE ? rest : (rest >> 1);
        const int Lsh = gg == 0 ? 11 : (gg == 1 ? 9 : 7);
        const int q0 = qblk * 256, cs0 = (q0 >> Lsh) << Lsh, kv0 = (q0 - 128) > cs0 ? (q0 - 128) : cs0;
        const bf16* Qp = QKV + (size_t)gg * 6144 + h * 128; const bf16* Kp = Qp + 2048; const bf16* Vp = Qp + 4096;
        __syncthreads();
        for (int i = F.tid; i < (q0 + 256 - kv0) * 16; i += NTHR) { const int v = kv0 + (i >> 4), ch = i & 15;
            const v4u val = *(const GAS v4u*)(Vp + (size_t)tokrow(b, v, Lsh) * NQKV + ch * 8);
            *(LAS v4u*)(F.lds + (v - (q0 - 128)) * VROW + ch * 16) = val; }
        __syncthreads();
        const int qw0 = q0 + 32 * F.wave, cs = (qw0 >> Lsh) << Lsh;
        const int qrow = tokrow(b, qw0 + ql, Lsh);
        bf16x8 qf[8];
#pragma unroll
        for (int s = 0; s < 8; ++s) qf[s] = *(const GAS bf16x8*)(Qp + (size_t)qrow * NQKV + 16 * s + 8 * hh);
        f32x16 S[5];
#define LOADK(dst, kb_) do { const int ks_ = qw0 - 128 + 32 * (kb_); if (ks_ >= cs) { const bf16* kp_ = Kp + (size_t)tokrow(b, ks_ + ql, Lsh) * NQKV + 8 * hh; \
        _Pragma("unroll") for (int s_ = 0; s_ < 8; ++s_) dst[s_] = *(const GAS bf16x8*)(kp_ + 16 * s_); } } while (0)
#define QKBLK(kf_, kb_) do { _Pragma("unroll") for (int r_ = 0; r_ < 16; ++r_) S[kb_][r_] = 0.f; \
        if ((qw0 - 128 + 32 * (kb_)) >= cs) { _Pragma("unroll") for (int s_ = 0; s_ < 8; ++s_) S[kb_] = __builtin_amdgcn_mfma_f32_32x32x16_bf16(kf_[s_], qf[s_], S[kb_], 0, 0, 0); } \
        __builtin_amdgcn_sched_barrier(0); } while (0)
        {
            bf16x8 ka[8], kbf[8];
#pragma unroll
            for (int s_ = 0; s_ < 8; ++s_) { ka[s_] = (bf16x8){0, 0, 0, 0, 0, 0, 0, 0}; kbf[s_] = ka[s_]; }
            LOADK(ka, 0); __builtin_amdgcn_sched_barrier(0);
            LOADK(kbf, 1); QKBLK(ka, 0);
            LOADK(ka, 2); QKBLK(kbf, 1);
            LOADK(kbf, 3); QKBLK(ka, 2);
            LOADK(ka, 4); QKBLK(kbf, 3);
            QKBLK(ka, 4);
        }
#undef LOADK
#undef QKBLK
        const float c1 = 0.08838834764831845f * 1.4426950408889634f;
        const float sl2 = exp2f(-8.0f * (float)(gg * 16 + h + 1) / 48.0f) * (float)(1 << (11 - Lsh)) * 1.4426950408889634f;
        const float lb = -sl2 * (float)(ql - 4 * hh);
        float mx = -3.0e38f;
#pragma unroll
        for (int kb = 0; kb < 5; ++kb) { const bool live = (qw0 - 128 + 32 * kb) >= cs;
#pragma unroll
            for (int r = 0; r < 16; ++r) { const int cr = (r & 3) + 8 * (r >> 2);
                float sc = S[kb][r] * c1 + (sl2 * (float)(cr - 128 + 32 * kb) + lb);
                if (kb == 0) sc = (cr + 4 * hh >= ql) ? sc : -1.0e30f;
                if (kb == 4) sc = (cr + 4 * hh <= ql) ? sc : -1.0e30f;
                sc = live ? sc : -1.0e30f;
                S[kb][r] = sc; mx = fmaxf(mx, sc); } }
        mx = fmaxf(mx, __shfl_xor(mx, 32));
        float l = 0.f;
#pragma unroll
        for (int kb = 0; kb < 5; ++kb)
#pragma unroll
            for (int r = 0; r < 16; ++r) { const float p = __builtin_amdgcn_exp2f(S[kb][r] - mx); S[kb][r] = p; l += p; }
        l += __shfl_xor(l, 32);
        f32x16 o[4];
#pragma unroll
        for (int c = 0; c < 4; ++c)
#pragma unroll
            for (int r = 0; r < 16; ++r) o[c][r] = 0.f;
        const unsigned va0 = ldsb + (unsigned)((4 * hh + ((lane & 15) >> 2)) * VROW + (16 * ((lane >> 4) & 1) + 4 * (lane & 3)) * 2);
#pragma unroll
        for (int kb = 0; kb < 5; ++kb) {
            if ((qw0 - 128 + 32 * kb) >= cs) {
#pragma unroll
                for (int s = 0; s < 2; ++s) {
                    const unsigned va = va0 + (unsigned)((32 * F.wave + 32 * kb + 16 * s) * VROW);
                    const s16x4 l0 = tr_read<0>(va), h0 = tr_read<8 * VROW>(va), l1 = tr_read<64>(va), h1 = tr_read<64 + 8 * VROW>(va);
                    const s16x4 l2 = tr_read<128>(va), h2 = tr_read<128 + 8 * VROW>(va), l3 = tr_read<192>(va), h3 = tr_read<192 + 8 * VROW>(va);
                    v4u pw; pw.x = pg8::cvt_pk_bf16(S[kb][8 * s + 0], S[kb][8 * s + 1]); pw.y = pg8::cvt_pk_bf16(S[kb][8 * s + 2], S[kb][8 * s + 3]);
                    pw.z = pg8::cvt_pk_bf16(S[kb][8 * s + 4], S[kb][8 * s + 5]); pw.w = pg8::cvt_pk_bf16(S[kb][8 * s + 6], S[kb][8 * s + 7]);
                    const bf16x8 pb = __builtin_bit_cast(bf16x8, pw);
                    asm volatile("s_waitcnt lgkmcnt(0)" ::: "memory"); __builtin_amdgcn_sched_barrier(0);
#define PKV(L, H) (bf16x8){L[0], L[1], L[2], L[3], H[0], H[1], H[2], H[3]}
                    o[0] = __builtin_amdgcn_mfma_f32_32x32x16_bf16(PKV(l0, h0), pb, o[0], 0, 0, 0);
                    o[1] = __builtin_amdgcn_mfma_f32_32x32x16_bf16(PKV(l1, h1), pb, o[1], 0, 0, 0);
                    o[2] = __builtin_amdgcn_mfma_f32_32x32x16_bf16(PKV(l2, h2), pb, o[2], 0, 0, 0);
                    o[3] = __builtin_amdgcn_mfma_f32_32x32x16_bf16(PKV(l3, h3), pb, o[3], 0, 0, 0);
#undef PKV
                }
            }
        }
        const float inv = 1.0f / l, lse0 = mx + __builtin_amdgcn_logf(l);
        if (!COMBINE) {
            bf16* orow = O12 + (size_t)(gg - 1) * M * D + (size_t)qrow * D + h * 128 + 4 * hh;
#pragma unroll
            for (int c = 0; c < 4; ++c)
#pragma unroll
                for (int g4 = 0; g4 < 4; ++g4) { v2u w; w.x = pg8::cvt_pk_bf16(o[c][4 * g4] * inv, o[c][4 * g4 + 1] * inv); w.y = pg8::cvt_pk_bf16(o[c][4 * g4 + 2] * inv, o[c][4 * g4 + 3] * inv);
                    *(GAS v2u*)(orow + 32 * c + 8 * g4) = w; }
            if (hh == 0) LSE[(size_t)(gg - 1) * M * 16 + (size_t)qrow * 16 + h] = lse0;
        } else {
            const float l1 = LSE[(size_t)qrow * 16 + h], l2 = LSE[(size_t)M * 16 + (size_t)qrow * 16 + h];
            const float mm = fmaxf(lse0, fmaxf(l1, l2));
            const float e0 = __builtin_amdgcn_exp2f(lse0 - mm), e1 = __builtin_amdgcn_exp2f(l1 - mm), e2 = __builtin_amdgcn_exp2f(l2 - mm);
            const float rd = 1.0f / (e0 + e1 + e2), w0 = e0 * inv * rd, w1 = e1 * rd, w2 = e2 * rd;
            const bf16* o1p = O12 + (size_t)qrow * D + h * 128 + 4 * hh; const bf16* o2p = o1p + (size_t)M * D;
            bf16* orow = MO + (size_t)qrow * D + h * 128 + 4 * hh;
#pragma unroll
            for (int c = 0; c < 4; ++c)
#pragma unroll
                for (int g4 = 0; g4 < 4; ++g4) { const v2u a = *(const GAS v2u*)(o1p + 32 * c + 8 * g4), bq = *(const GAS v2u*)(o2p + 32 * c + 8 * g4);
                    const float r0 = w0 * o[c][4 * g4] + w1 * bfl(a.x) + w2 * bfl(bq.x), r1 = w0 * o[c][4 * g4 + 1] + w1 * bfh(a.x) + w2 * bfh(bq.x);
                    const float r2 = w0 * o[c][4 * g4 + 2] + w1 * bfl(a.y) + w2 * bfl(bq.y), r3 = w0 * o[c][4 * g4 + 3] + w1 * bfh(a.y) + w2 * bfh(bq.y);
                    v2u w; w.x = pg8::cvt_pk_bf16(r0, r1); w.y = pg8::cvt_pk_bf16(r2, r3); *(GAS v2u*)(orow + 32 * c + 8 * g4) = w; }
        }
    }
    __syncthreads();
}

__device__ __forceinline__ void unpack8(const v4u w, float (&f)[8]) { f[0] = bfl(w.x); f[1] = bfh(w.x); f[2] = bfl(w.y); f[3] = bfh(w.y); f[4] = bfl(w.z); f[5] = bfh(w.z); f[6] = bfl(w.w); f[7] = bfh(w.w); }
__device__ __forceinline__ v4u pack8(const float (&f)[8]) { v4u w; w.x = pk2(f[0], f[1]); w.y = pk2(f[2], f[3]); w.z = pk2(f[4], f[5]); w.w = pk2(f[6], f[7]); return w; }
__device__ __forceinline__ void ffn_act_phase(Frame& F, const bf16* GU, bf16* ACT, const float* cw, const float* cb) {
    F.ids();
    constexpr int C8 = FF / 8;
    const size_t total = (size_t)(M / 4) * C8;
    for (size_t i = (size_t)F.vcu * NTHR + F.tid; i < total; i += (size_t)F.G * NTHR) {
        const int rg = (int)(i / C8), c8 = (int)(i % C8), r0 = rg * 4, t0 = r0 & (SEQ - 1), c = c8 * 8;
        float w0[8], w1[8], w2[8], bb[8];
#pragma unroll
        for (int j = 0; j < 8; ++j) { w0[j] = cw[c + j]; w1[j] = cw[FF + c + j]; w2[j] = cw[2 * FF + c + j]; bb[j] = cb[c + j]; }
        float g[6][8];
#pragma unroll
        for (int k = 0; k < 6; ++k) { const int t = t0 - 2 + k;
            if (t >= 0) unpack8(*(const GAS v4u*)(GU + (size_t)(r0 - 2 + k) * (2 * FF) + c), g[k]);
            else {
#pragma unroll
                for (int j = 0; j < 8; ++j) g[k][j] = 0.f; } }
#pragma unroll
        for (int k = 0; k < 4; ++k) { float up[8], o[8]; unpack8(*(const GAS v4u*)(GU + (size_t)(r0 + k) * (2 * FF) + FF + c), up);
#pragma unroll
            for (int j = 0; j < 8; ++j) { const float z = w0[j] * g[k][j] + w1[j] * g[k + 1][j] + w2[j] * g[k + 2][j] + bb[j]; o[j] = z * pg8::fast_sigmoid(z) * up[j]; }
            *(GAS v4u*)(ACT + (size_t)(r0 + k) * FF + c) = pack8(o); }
    }
}
__device__ __forceinline__ void conv_mix_phase(Frame& F, const bf16* BCU, bf16* Z, const float* cw) {
    F.ids();
    constexpr int C8 = D / 8;
    const size_t total = (size_t)(M / 4) * C8;
    for (size_t i = (size_t)F.vcu * NTHR + F.tid; i < total; i += (size_t)F.G * NTHR) {
        const int rg = (int)(i / C8), c8 = (int)(i % C8), r0 = rg * 4, t0 = r0 & (SEQ - 1), c = c8 * 8;
        float w0[8], w1[8], w2[8];
#pragma unroll
        for (int j = 0; j < 8; ++j) { w0[j] = cw[c + j]; w1[j] = cw[D + c + j]; w2[j] = cw[2 * D + c + j]; }
        float cu[6][8];
#pragma unroll
        for (int k = 0; k < 6; ++k) { const int t = t0 - 2 + k;
            if (t >= 0) { float a[8], b2[8]; const bf16* rp = BCU + (size_t)(r0 - 2 + k) * (3 * D) + c; unpack8(*(const GAS v4u*)(rp + D), a); unpack8(*(const GAS v4u*)(rp + 2 * D), b2);
#pragma unroll
                for (int j = 0; j < 8; ++j) cu[k][j] = a[j] * b2[j]; }
            else {
#pragma unroll
                for (int j = 0; j < 8; ++j) cu[k][j] = 0.f; } }
#pragma unroll
        for (int k = 0; k < 4; ++k) { float gb[8], o[8]; unpack8(*(const GAS v4u*)(BCU + (size_t)(r0 + k) * (3 * D) + c), gb);
#pragma unroll
            for (int j = 0; j < 8; ++j) o[j] = gb[j] * (w0[j] * cu[k][j] + w1[j] * cu[k + 1][j] + w2[j] * cu[k + 2][j]);
            *(GAS v4u*)(Z + (size_t)(r0 + k) * D + c) = pack8(o); }
    }
}

__device__ __forceinline__ void rwkv_mix_phase(Frame& F, const float* X, const float* ssq, const float* gn, const float* mu, bf16* MIX) {
    F.ids();
    const int gw = F.vcu * NWAVES + F.wave, NGW = F.G * NWAVES, lane = F.lane;
    for (int m = gw; m < M; m += NGW) {
        const int t = m & (SEQ - 1);
        float s1 = lane < 32 ? ssq[(size_t)m * 32 + lane] : 0.f, s0 = (lane < 32 && t > 0) ? ssq[(size_t)(m - 1) * 32 + lane] : 0.f;
        s1 = wave_sum(s1); s0 = wave_sum(s0);
        const float r1 = __builtin_amdgcn_rsqf(s1 * (1.0f / D) + 1e-6f), r0 = t > 0 ? __builtin_amdgcn_rsqf(s0 * (1.0f / D) + 1e-6f) : 0.f;
        const GAS f32x4* x1 = (const GAS f32x4*)(X + (size_t)m * D) + lane; const GAS f32x4* x0 = (const GAS f32x4*)(X + (size_t)(t > 0 ? m - 1 : m) * D) + lane;
        const GAS f32x4* g4 = (const GAS f32x4*)gn + lane; const GAS f32x4* mu4 = (const GAS f32x4*)mu + lane;
#pragma unroll 2
        for (int j = 0; j < 8; ++j) { const f32x4 gv = g4[64 * j]; const f32x4 hv = x1[64 * j] * gv * r1, hp = x0[64 * j] * gv * r0, xx = hp - hv;
#pragma unroll
            for (int i = 0; i < 6; ++i) { const f32x4 o = hv + xx * mu4[i * (D / 4) + 64 * j]; v2u w; w.x = pk2(o[0], o[1]); w.y = pk2(o[2], o[3]);
                *((GAS v2u*)(MIX + (size_t)i * M * D + (size_t)m * D) + lane + 64 * j) = w; } }
    }
}

constexpr int SC_T = 32, SC_ARR = SC_T * 64 * 4, SC_BUF = 5 * SC_ARR + SC_T * 32 * 4, SC_YOFF = 2 * SC_BUF, SC_YB = SC_T * 32 * 4;
__device__ __forceinline__ void rwkv_scan_phase(Frame& F, const float* RKV, const float* WAG, const float* k_k, const float* k_a, float* Y) {
    F.ids();
    const int tid = F.tid, lane = F.lane, wave = F.wave;
    for (int item = F.vcu; item < NB * 32 * 2; item += F.G) {
        const int half = item & 1, h = (item >> 1) & 31, b = item >> 6;
        const size_t gbase = (size_t)b * SEQ * D + h * 64;
        __syncthreads();
        if (wave >= 4) {
            const int st = tid - 256, ts = st >> 4, c4 = st & 15;
            const f32x4 kkc = *(const GAS f32x4*)(k_k + h * 64 + 4 * c4), kac = *(const GAS f32x4*)(k_a + h * 64 + 4 * c4);
            for (int ci = -1; ci < SEQ / SC_T; ++ci) {
                if (ci >= 1) {
                    const int t = st >> 3, v4 = st & 7; const LAS float* yb = (const LAS float*)(F.lds + SC_YOFF + ((ci - 1) & 1) * SC_YB);
                    *(GAS f32x4*)(Y + gbase + (size_t)((ci - 1) * SC_T + t) * D + 32 * half + 4 * v4) = *(const LAS f32x4*)(yb + t * 32 + 4 * v4);
                }
                if (ci + 1 < SEQ / SC_T) {
                    LAS unsigned char* bp = F.lds + ((ci + 1) & 1) * SC_BUF;
#pragma unroll
                    for (int ps = 0; ps < 2; ++ps) { const int tt = ts + 16 * ps; const size_t go = gbase + (size_t)((ci + 1) * SC_T + tt) * D + 4 * c4;
                        const f32x4 r4 = *(const GAS f32x4*)(RKV + go), k4 = *(const GAS f32x4*)(RKV + (size_t)M * D + go), v4 = *(const GAS f32x4*)(RKV + 2 * (size_t)M * D + go);
                        const f32x4 w4 = *(const GAS f32x4*)(WAG + go), a4 = *(const GAS f32x4*)(WAG + (size_t)M * D + go);
                        const f32x4 kr = k4 * kkc; float n2 = (kr[0] * kr[0] + kr[1] * kr[1]) + (kr[2] * kr[2] + kr[3] * kr[3]); n2 = red16(n2);
                        const float rn = 1.0f / fmaxf(sqrtf(n2), 1e-12f); const f32x4 kk = kr * rn;
                        const f32x4 kn = k4 * (1.0f + (a4 - 1.0f) * kac);
                        const int lo = tt * 64 + 4 * c4;
                        *(LAS f32x4*)(bp + 0 * SC_ARR + lo * 4) = r4; *(LAS f32x4*)(bp + 1 * SC_ARR + lo * 4) = w4; *(LAS f32x4*)(bp + 2 * SC_ARR + lo * 4) = kn;
                        *(LAS f32x4*)(bp + 3 * SC_ARR + lo * 4) = -kk; *(LAS f32x4*)(bp + 4 * SC_ARR + lo * 4) = kk * a4;
                        if ((c4 >> 3) == half) *(LAS f32x4*)(bp + 5 * SC_ARR + (tt * 32 + 4 * (c4 & 7)) * 4) = v4; }
                }
                __syncthreads();
            }
            {   const int ci = SEQ / SC_T; const int t = st >> 3, v4 = st & 7; const LAS float* yb = (const LAS float*)(F.lds + SC_YOFF + ((ci - 1) & 1) * SC_YB);
                *(GAS f32x4*)(Y + gbase + (size_t)((ci - 1) * SC_T + t) * D + 32 * half + 4 * v4) = *(const LAS f32x4*)(yb + t * 32 + 4 * v4); }
        } else {
            const int row = lane >> 3, kg = lane & 7, vr = 8 * wave + row;
            float s[8];
#pragma unroll
            for (int i = 0; i < 8; ++i) s[i] = 0.f;
            __syncthreads();
            for (int ci = 0; ci < SEQ / SC_T; ++ci) {
                const LAS unsigned char* bp = F.lds + (ci & 1) * SC_BUF; LAS float* yb = (LAS float*)(F.lds + SC_YOFF + (ci & 1) * SC_YB);
#pragma unroll 4
                for (int t = 0; t < SC_T; ++t) {
                    const int lo = (t * 64 + 8 * kg) * 4;
                    const f32x4 ra = *(const LAS f32x4*)(bp + 0 * SC_ARR + lo), rb = *(const LAS f32x4*)(bp + 0 * SC_ARR + lo + 16);
                    const f32x4 wa = *(const LAS f32x4*)(bp + 1 * SC_ARR + lo), wb = *(const LAS f32x4*)(bp + 1 * SC_ARR + lo + 16);
                    const f32x4 ka = *(const LAS f32x4*)(bp + 2 * SC_ARR + lo), kb = *(const LAS f32x4*)(bp + 2 * SC_ARR + lo + 16);
                    const f32x4 aa = *(const LAS f32x4*)(bp + 3 * SC_ARR + lo), ab = *(const LAS f32x4*)(bp + 3 * SC_ARR + lo + 16);
                    const f32x4 ba = *(const LAS f32x4*)(bp + 4 * SC_ARR + lo), bb = *(const LAS f32x4*)(bp + 4 * SC_ARR + lo + 16);
                    const float vv = *(const LAS float*)(bp + 5 * SC_ARR + (t * 32 + vr) * 4);
                    float sa = ((s[0] * aa[0] + s[1] * aa[1]) + (s[2] * aa[2] + s[3] * aa[3])) + ((s[4] * ab[0] + s[5] * ab[1]) + (s[6] * ab[2] + s[7] * ab[3]));
                    sa = red8(sa);
#pragma unroll
                    for (int i = 0; i < 4; ++i) { s[i] = s[i] * wa[i] + (sa * ba[i] + vv * ka[i]); s[4 + i] = s[4 + i] * wb[i] + (sa * bb[i] + vv * kb[i]); }
                    float y = ((s[0] * ra[0] + s[1] * ra[1]) + (s[2] * ra[2] + s[3] * ra[3])) + ((s[4] * rb[0] + s[5] * rb[1]) + (s[6] * rb[2] + s[7] * rb[3]));
                    y = red8(y);
                    if (kg == 0) yb[t * 32 + vr] = y;
                }
                __syncthreads();
            }
        }
    }
    __syncthreads();
}

__device__ __forceinline__ void rwkv_post_phase(Frame& F, const float* Y, const float* RKV, const float* WAG, const float* k_a, const float* r_k, const float* ln_g, const float* ln_b, bf16* MO) {
    F.ids();
    const int gw = F.vcu * NWAVES + F.wave, NGW = F.G * NWAVES, lane = F.lane;
    for (int it = gw; it < M * 32; it += NGW) {
        const int row = it >> 5, h = it & 31, c = h * 64 + lane; const size_t o = (size_t)row * D + c;
        const float y = Y[o], r = RKV[o], k = RKV[(size_t)M * D + o], v = RKV[2 * (size_t)M * D + o], a = WAG[(size_t)M * D + o], g = WAG[2 * (size_t)M * D + o];
        const float mean = wave_sum(y) * (1.0f / 64.0f), dy = y - mean, var = wave_sum(dy * dy) * (1.0f / 64.0f);
        const float yn = dy * __builtin_amdgcn_rsqf(var + 6.4e-4f) * ln_g[c] + ln_b[c];
        const float kn = k * (1.0f + (a - 1.0f) * k_a[c]);
        const float bonus = wave_sum(r * kn * r_k[c]) * v;
        MO[o] = (bf16)f2bf((yn + bonus) * g);
    }
}

__device__ __forceinline__ void final_norm_phase(Frame& F, float* X, const float* gn) {
    F.ids();
    const int gw = F.vcu * NWAVES + F.wave, NGW = F.G * NWAVES, lane = F.lane;
    for (int m = gw; m < M; m += NGW) {
        GAS f32x4* xr = (GAS f32x4*)(X + (size_t)m * D) + lane; const GAS f32x4* g4 = (const GAS f32x4*)gn + lane;
        f32x4 v[8]; float s = 0.f;
#pragma unroll
        for (int j = 0; j < 8; ++j) { v[j] = xr[64 * j]; s += (v[j][0] * v[j][0] + v[j][1] * v[j][1]) + (v[j][2] * v[j][2] + v[j][3] * v[j][3]); }
        const float rs = __builtin_amdgcn_rsqf(wave_sum(s) * (1.0f / D) + 1e-6f);
#pragma unroll
        for (int j = 0; j < 8; ++j) xr[64 * j] = v[j] * rs * g4[64 * j];
    }
}

constexpr int NPH = 43;
__host__ __device__ constexpr bool phase_used(int ph) {
    if (ph < 2 || ph == NPH - 1) return true;
    const int L = (ph - 2) / 10, s = (ph - 2) % 10, kind = L % 3;
    if (s >= 6) return true;
    return kind == 0 ? s < 4 : (kind == 1 ? true : s < 3);
}

#define IN(k) (lo <= (k) && (k) < hi)
#if MK_PER_PHASE
#define SEAM(k) do { } while (0)
#else
#define SEAM(k) do { if ((k) + 1 < hi) xcd_barrier(bar); } while (0)
#endif
#define ws ((unsigned char*)in_ptr(F, T_WS))
#define XO ((float*)in_ptr(F, T_OUT))
#define INP(i) in_ptr(F, (i))
#define MO ((bf16*)(ws + WS_MO))
#define scr (ws + WS_SCR)
template <int L> __device__ __forceinline__ void layer_phases(Frame& F, const int lo, const int hi, const XcdBarrier& bar, const int bid) {
    constexpr int pb = 2 + 10 * L, kind = L % 3, j = L / 3, ver = 3 * L;
#define xcur ((L == 0) ? INP(I_X) : (const float*)XO)
#define XB0 ((bf16*)(ws + WS_XB))
#define SQ0 ((float*)(ws + WS_SSQ))
#define XBV(v) (XB0 + (size_t)((v) & 1) * M * D)
#define SQV(v) (SQ0 + (size_t)((v) & 1) * M * 32)
#define Wout ((const bf16*)(ws + (kind == 0 ? WS_WAO + (size_t)j * 8 * MiB : (kind == 1 ? WS_WRO : WS_WCOUT))))
    if constexpr (kind == 0) {
#define QKV ((bf16*)(scr + SC_QKV))
#define O12 ((bf16*)(scr + SC_O12))
#define LSE ((float*)(scr + SC_LSE))
        if (IN(pb + 0)) {
            pg8::Gemm g{XBV(ver), (const bf16*)(ws + WS_WQKV + (size_t)j * 72 * MiB), M, NQKV, D, 0, 1 << 30, 1 << 30};
            pg8::StaticOrder S; S.init(M, NQKV, F.G, bid);
            pg8::EpiScaleBf16<true> E{QKV, NQKV, SQV(ver), 0, 0};
            pg8::gemm_phase<pg8::EpiScaleBf16<true>, pg8::StaticOrder, true, true>(F.lds, g, S, E, F.wave);
            SEAM(pb + 0);
        }
        if (IN(pb + 1)) { attn_phase<false>(F, QKV, O12, LSE, MO); SEAM(pb + 1); }
        if (IN(pb + 2)) { attn_phase<true>(F, QKV, O12, LSE, MO); SEAM(pb + 2); }
    } else if constexpr (kind == 1) {
#define MIX ((bf16*)(scr + SC_MIX))
#define WAG ((float*)(scr + SC_WAG))
#define RKV ((float*)(scr + SC_RKV))
#define T1 ((bf16*)(scr + SC_T1))
#define YB ((float*)(scr + SC_Y))
        if (IN(pb + 0)) { rwkv_mix_phase(F, xcur, SQV(ver), INP(I_RWKV_NORM) + (size_t)j * D, INP(I_RWKV_MU) + (size_t)j * 6 * D, MIX); SEAM(pb + 0); }
        if (IN(pb + 1)) {
            pg8::Gemm g{MIX, (const bf16*)(ws + WS_WR1), M, 6912, D, (size_t)M * D * 2, 8, 24};
            pg8::StaticOrder S; S.init(M, 6912, F.G, bid);
            pg8::EpiR1 E{RKV, T1, M};
            pg8::gemm_phase<pg8::EpiR1, pg8::StaticOrder, true, true>(F.lds, g, S, E, F.wave);
            SEAM(pb + 1);
        }
        if (IN(pb + 2)) {
            pg8::Gemm g{T1, (const bf16*)(ws + WS_WR2), M, 3 * D, 256, (size_t)M * 256 * 2, 8, 1 << 30};
            pg8::StaticOrder S; S.init(M, 3 * D, F.G, bid);
            pg8::EpiR2 E{WAG, INP(I_RWKV_W0) + (size_t)j * D, INP(I_RWKV_A0) + (size_t)j * D, M};
            pg8::gemm_phase<pg8::EpiR2, pg8::StaticOrder, true, true>(F.lds, g, S, E, F.wave);
            SEAM(pb + 2);
        }
        if (IN(pb + 3)) { rwkv_scan_phase(F, RKV, WAG, INP(I_RWKV_KK) + (size_t)j * D, INP(I_RWKV_KA) + (size_t)j * D, YB); SEAM(pb + 3); }
        if (IN(pb + 4)) { rwkv_post_phase(F, YB, RKV, WAG, INP(I_RWKV_KA) + (size_t)j * D, INP(I_RWKV_RK) + (size_t)j * D, INP(I_RWKV_LNG) + (size_t)j * D, INP(I_RWKV_LNB) + (size_t)j * D, MO); SEAM(pb + 4); }
    } else {
#define BCU ((bf16*)(scr + SC_BCU))
        if (IN(pb + 0)) {
            pg8::Gemm g{XBV(ver), (const bf16*)(ws + WS_WCIN), M, 3 * D, D, 0, 1 << 30, 1 << 30};
            pg8::StaticOrder S; S.init(M, 3 * D, F.G, bid);
            pg8::EpiScaleBf16<true> E{BCU, 3 * D, SQV(ver), 0, 0};
            pg8::gemm_phase<pg8::EpiScaleBf16<true>, pg8::StaticOrder, true, true>(F.lds, g, S, E, F.wave);
            SEAM(pb + 0);
        }
        if (IN(pb + 1)) { conv_mix_phase(F, BCU, MO, INP(I_CONV_W) + (size_t)j * 3 * D); SEAM(pb + 1); }
    }
    constexpr int ps_out = pb + (kind == 0 ? 3 : (kind == 1 ? 5 : 2));
    if (IN(ps_out)) {
        pg8::Gemm g{MO, Wout, M, D, D, 0, 1 << 30, 1 << 30};
        pg8::StaticOrder S; S.init(M, D, F.G, bid);
        pg8::EpiResid E{xcur, XO, XBV(ver + 1), SQV(ver + 1)};
        pg8::gemm_phase<pg8::EpiResid, pg8::StaticOrder, true, true>(F.lds, g, S, E, F.wave);
        SEAM(ps_out);
    }
#define GU ((bf16*)(scr + SC_GU))
#define ACT ((bf16*)(scr + SC_ACT))
    if (IN(pb + 6)) {
        pg8::Gemm g{XBV(ver + 1), (const bf16*)(ws + WS_WGU + (size_t)L * 44 * MiB), M, 2 * FF, D, 0, 1 << 30, 1 << 30};
        pg8::StaticOrder S; S.init(M, 2 * FF, F.G, bid);
        pg8::EpiScaleBf16<true> E{GU, 2 * FF, SQV(ver + 1), 0, 0};
        pg8::gemm_phase<pg8::EpiScaleBf16<true>, pg8::StaticOrder, true, true>(F.lds, g, S, E, F.wave);
        SEAM(pb + 6);
    }
    if (IN(pb + 7)) { ffn_act_phase(F, GU, ACT, INP(I_FFN_CONVW) + (size_t)L * 3 * FF, INP(I_FFN_CONVB) + (size_t)L * FF); SEAM(pb + 7); }
    if (IN(pb + 8)) {
        pg8::Gemm g{ACT, (const bf16*)(ws + WS_WDN + (size_t)L * 22 * MiB), M, D, FF, 0, 1 << 30, 1 << 30};
        pg8::StaticOrder S; S.init(M, D, F.G, bid);
        pg8::EpiResid E{XO, XO, XBV(ver + 2), SQV(ver + 2)};
        pg8::gemm_phase<pg8::EpiResid, pg8::StaticOrder, true, true>(F.lds, g, S, E, F.wave);
        SEAM(pb + 8);
    }
    if (IN(pb + 9)) {
        pg8::Gemm g{XBV(ver + 2), (const bf16*)(ws + WS_WPG + (size_t)L * 8 * MiB), M, D, D, 0, 1 << 30, 1 << 30};
        pg8::StaticOrder S; S.init(M, D, F.G, bid);
        pg8::EpiPle E{SQV(ver + 2), XO, (const bf16*)(ws + WS_PPO) + (size_t)L * M * D, XO, XBV(ver + 3), SQV(ver + 3)};
        pg8::gemm_phase<pg8::EpiPle, pg8::StaticOrder, true, true>(F.lds, g, S, E, F.wave);
        SEAM(pb + 9);
    }
}

__global__ void __launch_bounds__(NTHR, 2) mega_fwd(Params P) {
    extern __shared__ __attribute__((aligned(16))) unsigned char lds_raw[];
    Frame F;
    F.lds = (LAS unsigned char*)lds_raw;
    F.wave = __builtin_amdgcn_readfirstlane((int)threadIdx.x >> 6); F.ids();
    F.G = gridDim.x; { const int bx = blockIdx.x; F.vcu = (F.G % 8 == 0) ? (bx % 8) * (F.G / 8) + bx / 8 : bx; }
    volatile LAS unsigned* MISC = (volatile LAS unsigned*)(F.lds + MISC_OFF);
    for (int u = F.tid; u < (LDS_BYTES - RING_BYTES) / 4; u += NTHR) ((LAS unsigned*)(F.lds + RING_BYTES))[u] = 0u;
    __syncthreads();
    if (F.tid == 0) {
#pragma unroll
        for (int i = 0; i < 35; ++i) ((LAS unsigned long long*)(F.lds + PTR_OFF))[i] = (unsigned long long)(size_t)P.in[i];
        ((LAS unsigned long long*)(F.lds + PTR_OFF))[T_OUT] = (unsigned long long)(size_t)P.out; ((LAS unsigned long long*)(F.lds + PTR_OFF))[T_WS] = (unsigned long long)(size_t)P.wsp; }
    __syncthreads();
    XcdBarrier bar; bar.bar = (unsigned*)(P.wsp + WS_CTL) + CW_BAR; bar.x = 0; bar.st = nullptr;
#if !MK_PER_PHASE
    bar = xcd_barrier_post((unsigned*)(P.wsp + WS_CTL) + CW_BAR, MISC + 8);
#endif
    const int lo = P.lo, hi = P.hi;
    const int bid = (int)blockIdx.x;

    if (IN(0)) { p_prologue(F); SEAM(0); }
    if (IN(1)) {
        pg8::Gemm g{(const bf16*)(ws + WS_PB), (const bf16*)(ws + WS_WPP), M, 4 * D, PLE, (size_t)M * PLE * 2, 8, 1 << 30};
        pg8::StaticOrder S; S.init(M, 4 * D, F.G, bid);
        pg8::EpiScaleBf16<false> E{(bf16*)(ws + WS_PPO), D, nullptr, D, (size_t)M * D};
        pg8::gemm_phase<pg8::EpiScaleBf16<false>, pg8::StaticOrder, true, true>(F.lds, g, S, E, F.wave);
        SEAM(1);
    }
    layer_phases<0>(F, lo, hi, bar, bid);
    layer_phases<1>(F, lo, hi, bar, bid);
    layer_phases<2>(F, lo, hi, bar, bid);
    layer_phases<3>(F, lo, hi, bar, bid);
    if (IN(NPH - 1)) final_norm_phase(F, XO, INP(I_FINAL_NORM));
#undef IN
#undef SEAM
#undef ws
#undef XO
#undef INP
#undef MO
#undef scr
#undef xcur
#undef XB0
#undef SQ0
#undef Wout
#undef QKV
#undef O12
#undef LSE
#undef MIX
#undef WAG
#undef RKV
#undef T1
#undef YB
#undef BCU
#undef GU
#undef ACT
#undef XBV
#undef SQV
}

extern "C" void kernel_launch(void* const* d_in, const int* in_sizes, int n_in, void* d_out, int out_size, void* d_ws, size_t ws_size, hipStream_t stream) {
    static int grid = 0;
    if (grid == 0) {
        if (n_in != 35 || out_size != M * D || ws_size < WS_END) { fprintf(stderr, "kernel_launch: unexpected problem: n_in %d out %d ws %zu (need %zu)\n", n_in, out_size, ws_size, (size_t)WS_END); grid = -1; return; }
        int dev = 0, cus = 0, per_cu = 0;
        if (hipGetDevice(&dev) != hipSuccess || hipDeviceGetAttribute(&cus, hipDeviceAttributeMultiprocessorCount, dev) != hipSuccess) { grid = -1; return; }
        if (hipFuncSetAttribute((const void*)mega_fwd, hipFuncAttributeMaxDynamicSharedMemorySize, LDS_BYTES) != hipSuccess) { fprintf(stderr, "kernel_launch: hipFuncSetAttribute failed\n"); grid = -1; return; }
        if (hipOccupancyMaxActiveBlocksPerMultiprocessor(&per_cu, (const void*)mega_fwd, NTHR, LDS_BYTES) != hipSuccess || per_cu < 1) fprintf(stderr, "kernel_launch: occupancy query says %d blocks per CU\n", per_cu);
        (void)hipGetLastError();
        grid = cus;
    }
    if (grid < 0) return;
    if (hipMemsetAsync((char*)d_ws + WS_CTL, 0, CTL_ZERO_BYTES, stream) != hipSuccess) return;
    Params a{};
    for (int i = 0; i < 35; ++i) a.in[i] = (const float*)d_in[i];
    a.out = (float*)d_out; a.wsp = (unsigned char*)d_ws;
#if MK_PER_PHASE
    for (int ph = 0; ph < NPH; ++ph) { if (!phase_used(ph)) continue; a.lo = ph; a.hi = ph + 1; hipLaunchKernelGGL(mega_fwd, dim3(grid), dim3(NTHR), LDS_BYTES, stream, a); }
#else
    a.lo = 0; a.hi = NPH; hipLaunchKernelGGL(mega_fwd, dim3(grid), dim3(NTHR), LDS_BYTES, stream, a);
#endif
}
```

```cpp
#include <hip/hip_runtime.h>
#include <cstdio>
#include <cstdint>
__device__ __forceinline__ int fresh_lane() { int l; asm volatile("v_mbcnt_lo_u32_b32 %0, -1, 0\n\tv_mbcnt_hi_u32_b32 %0, -1, %0" : "=v"(l)); return l; }
#ifndef MK_PER_PHASE
#define MK_PER_PHASE 0
#endif
namespace pg8 {
#define PG8_LAS __attribute__((address_space(3)))
typedef unsigned short bf16_t;
typedef short bf16x8 __attribute__((ext_vector_type(8)));
typedef float f32x4 __attribute__((ext_vector_type(4)));
typedef unsigned u32x4 __attribute__((ext_vector_type(4)));
constexpr int BM = 256, BK = 64, HALF = 128, HTB = HALF * BK * 2  , STAGE_BYTES = 8 * HTB, NXCD = 8, WGM = 8;

__host__ __device__ __forceinline__ int lds_byte(int r, int c) { const int st = (r >> 4) * 2 + (c >> 5), rr = r & 15, cc = c & 31, ob = rr * 64 + cc * 2; return st * 1024 + (ob ^ (((ob >> 9) & 1) << 5)); }
__host__ __device__ __forceinline__ void stage_rc(int b, int& R, int& C) { const int st = b / 1024, sb = b % 1024, swz = sb ^ (((sb >> 9) & 1) << 5); R = (st >> 1) * 16 + swz / 64; C = (st & 1) * 32 + (swz % 64) / 2; }
__host__ __device__ __forceinline__ int perm32(int rho) { const int n = rho >> 4, i = rho & 15; return 8 * (i >> 2) + 4 * n + (i & 3); }

struct Unit { int pm, pn; };
struct Gemm { const bf16_t* A; const bf16_t* Bt; int M, N, K; size_t a_stride; int grp, nsplit;
    __device__ __forceinline__ int asel(int pn) const { return pn < nsplit ? pn / grp : pn - nsplit + nsplit / grp; } };

struct StaticOrder {
    int nM, nN, nwg, G, c;
    __host__ __device__ void init(int M, int N, int G_, int c_) { nM = M / BM; nN = N / BM; nwg = nM * nN; G = G_; c = c_; }
    __host__ __device__ bool next(int i, Unit& u) const {
        const long L = (long)i * G + c; if (L >= nwg) return false;
        int wgid = (int)L; { const int q = nwg / NXCD, r = nwg % NXCD, xcd = wgid % NXCD, off = wgid / NXCD; wgid = (xcd < r ? xcd * (q + 1) : r * (q + 1) + (xcd - r) * q) + off; }
        const int nig = WGM * nN, gid = wgid / nig, fm = gid * WGM, gsz = (nM - fm) < WGM ? (nM - fm) : WGM;
        u.pm = fm + ((wgid % nig) % gsz); u.pn = (wgid % nig) / gsz; return true;
    }
    __device__ __forceinline__ void a_ready(const Unit&) const {}
    __device__ __forceinline__ void done(const Unit&) const {}
};

__device__ __forceinline__ unsigned cvt_pk_bf16(float lo, float hi) { unsigned r; asm volatile("v_cvt_pk_bf16_f32 %0, %1, %2" : "=v"(r) : "v"(lo), "v"(hi)); return r; }
typedef float f32x2 __attribute__((ext_vector_type(2)));
typedef unsigned u32x2 __attribute__((ext_vector_type(2)));
constexpr int DM = 2048;
constexpr int NPART = 32;
__device__ __forceinline__ float bf2f(unsigned short b) { return __uint_as_float(((unsigned)b) << 16); }
__device__ __forceinline__ float fast_sigmoid(float z) { return __builtin_amdgcn_rcpf(1.0f + __expf(-z)); }

__device__ __forceinline__ void rows_rstd(const float* ssq, int row0, int fq, float (&rs)[2][4]) {
#pragma unroll
    for (int ai = 0; ai < 2; ++ai)
#pragma unroll
        for (int m = 0; m < 4; ++m) { const f32x4* p = (const f32x4*)(ssq + (size_t)(row0 + ai * HALF + m * 16) * NPART + fq * 8); const f32x4 a = p[0], b = p[1];
            float s = ((a[0] + a[1]) + (a[2] + a[3])) + ((b[0] + b[1]) + (b[2] + b[3])); s += __shfl_xor(s, 16); s += __shfl_xor(s, 32);
            rs[ai][m] = __builtin_amdgcn_rsqf(s * (1.0f / (float)DM) + 1e-6f); }
}

template <bool SCALE> struct EpiScaleBf16 {
    static constexpr bool PERM = true, AFTER_DRAIN = false;
    bf16_t* O; int ldc; const float* ssq; int split_cols; size_t split_stride;
    __device__ __forceinline__ void operator()(const f32x4 (&acc)[2][2][4][2], const Unit& u, int wr, int wc, int fr, int fq) const {
        const int row0 = u.pm * BM + wr * 64 + fr; int colt = u.pn * BM; bf16_t* base = O;
        if (split_cols) { const int t = colt / split_cols; base += (size_t)t * split_stride; colt -= t * split_cols; }
        const int col0 = colt + wc * 32 + 8 * fq;
        float rs[2][4];
        if (SCALE) rows_rstd(ssq, row0, fq, rs);
#pragma unroll
        for (int ai = 0; ai < 2; ++ai)
#pragma unroll
            for (int m = 0; m < 4; ++m) { bf16_t* rowp = base + (size_t)(row0 + ai * HALF + m * 16) * ldc + col0; const float sc = SCALE ? rs[ai][m] : 1.0f;
#pragma unroll
                for (int bj = 0; bj < 2; ++bj) { const f32x4 v0 = acc[ai][bj][m][0] * sc, v1 = acc[ai][bj][m][1] * sc;
                    u32x4 w; w.x = cvt_pk_bf16(v0[0], v0[1]); w.y = cvt_pk_bf16(v0[2], v0[3]); w.z = cvt_pk_bf16(v1[0], v1[1]); w.w = cvt_pk_bf16(v1[2], v1[3]);
                    *(u32x4*)(rowp + bj * HALF) = w; } }
    }
};

#define EPI_STORE_X(v, o) do { *(f32x4*)(X + (o)) = (v); u32x2 w_; w_.x = cvt_pk_bf16((v)[0], (v)[1]); w_.y = cvt_pk_bf16((v)[2], (v)[3]); *(u32x2*)(XB + (o)) = w_; \
        ss += ((v)[0] * (v)[0] + (v)[1] * (v)[1]) + ((v)[2] * (v)[2] + (v)[3] * (v)[3]); } while (0)

struct EpiResid {
    static constexpr bool PERM = false, AFTER_DRAIN = false;
    const float* base; float* X; bf16_t* XB; float* SSQ;
    __device__ __forceinline__ void operator()(const f32x4 (&acc)[2][2][4][2], const Unit& u, int wr, int wc, int fr, int fq) const {
        const int row0 = u.pm * BM + wr * 64 + fr, col0 = u.pn * BM + wc * 32 + 4 * fq;
#pragma unroll
        for (int ai = 0; ai < 2; ++ai)
#pragma unroll
            for (int m = 0; m < 4; ++m) { const int r = row0 + ai * HALF + m * 16; const size_t off = (size_t)r * DM + col0; float ss = 0.f;
#pragma unroll
                for (int bj = 0; bj < 2; ++bj)
#pragma unroll
                    for (int n = 0; n < 2; ++n) { const size_t o = off + bj * HALF + n * 16; const f32x4 v = *(const f32x4*)(base + o) + acc[ai][bj][m][n]; EPI_STORE_X(v, o); }
                ss += __shfl_xor(ss, 16); ss += __shfl_xor(ss, 32);
                if (fq == 0) SSQ[(size_t)r * NPART + u.pn * 4 + wc] = ss;
                if (m & 1) asm volatile("" ::: "memory"); }
    }
};

struct EpiPle {
    static constexpr bool PERM = false, AFTER_DRAIN = false;
    const float* ssq; const float* base; const bf16_t* PP; float* X; bf16_t* XB; float* SSQ;
    __device__ __forceinline__ void operator()(const f32x4 (&acc)[2][2][4][2], const Unit& u, int wr, int wc, int fr, int fq) const {
        const int row0 = u.pm * BM + wr * 64 + fr, col0 = u.pn * BM + wc * 32 + 4 * fq;
        float rs[2][4]; rows_rstd(ssq, row0, fq, rs);
#pragma unroll
        for (int ai = 0; ai < 2; ++ai)
#pragma unroll
            for (int m = 0; m < 4; ++m) { const int r = row0 + ai * HALF + m * 16; const size_t off = (size_t)r * DM + col0; float ss = 0.f; const float sc = rs[ai][m];
#pragma unroll
                for (int bj = 0; bj < 2; ++bj)
#pragma unroll
                    for (int n = 0; n < 2; ++n) { const size_t o = off + bj * HALF + n * 16; const f32x4 xv = *(const f32x4*)(base + o); const u32x2 pw = *(const u32x2*)(PP + o); const f32x4 a = acc[ai][bj][m][n];
                        f32x4 v; v[0] = xv[0] + fast_sigmoid(a[0] * sc) * __uint_as_float(pw.x << 16); v[1] = xv[1] + fast_sigmoid(a[1] * sc) * __uint_as_float(pw.x & 0xffff0000u);
                        v[2] = xv[2] + fast_sigmoid(a[2] * sc) * __uint_as_float(pw.y << 16); v[3] = xv[3] + fast_sigmoid(a[3] * sc) * __uint_as_float(pw.y & 0xffff0000u);
                        EPI_STORE_X(v, o); }
                ss += __shfl_xor(ss, 16); ss += __shfl_xor(ss, 32);
                if (fq == 0) SSQ[(size_t)r * NPART + u.pn * 4 + wc] = ss;
                if (m & 1) asm volatile("" ::: "memory"); }
    }
};

struct EpiR1 {
    static constexpr bool PERM = false, AFTER_DRAIN = false;
    float* RKV; bf16_t* T1; int M;
    __device__ __forceinline__ void operator()(const f32x4 (&acc)[2][2][4][2], const Unit& u, int wr, int wc, int fr, int fq) const {
        const int row0 = u.pm * BM + wr * 64 + fr, cl0 = wc * 32 + 4 * fq;
        if (u.pn < 24) {
            float* O = RKV + (size_t)(u.pn >> 3) * M * DM + (u.pn & 7) * BM + cl0;
#pragma unroll
            for (int ai = 0; ai < 2; ++ai)
#pragma unroll
                for (int m = 0; m < 4; ++m) { float* rowp = O + (size_t)(row0 + ai * HALF + m * 16) * DM;
#pragma unroll
                    for (int bj = 0; bj < 2; ++bj)
#pragma unroll
                        for (int n = 0; n < 2; ++n) *(f32x4*)(rowp + bj * HALF + n * 16) = acc[ai][bj][m][n]; }
        } else {
            const int mode = u.pn - 24; bf16_t* O = T1 + (size_t)mode * M * 256 + cl0;
#pragma unroll
            for (int ai = 0; ai < 2; ++ai)
#pragma unroll
                for (int m = 0; m < 4; ++m) { bf16_t* rowp = O + (size_t)(row0 + ai * HALF + m * 16) * 256;
#pragma unroll
                    for (int bj = 0; bj < 2; ++bj)
#pragma unroll
                        for (int n = 0; n < 2; ++n) { f32x4 v = acc[ai][bj][m][n];
                            if (mode == 0) {
#pragma unroll
                                for (int j = 0; j < 4; ++j) v[j] = 1.0f - 2.0f * __builtin_amdgcn_rcpf(1.0f + __expf(2.0f * v[j])); }
                            else if (mode == 2) {
#pragma unroll
                                for (int j = 0; j < 4; ++j) v[j] = fast_sigmoid(v[j]); }
                            u32x2 w; w.x = cvt_pk_bf16(v[0], v[1]); w.y = cvt_pk_bf16(v[2], v[3]); *(u32x2*)(rowp + bj * HALF + n * 16) = w; } }
        }
    }
};

struct EpiR2 {
    static constexpr bool PERM = false, AFTER_DRAIN = false;
    float* WAG; const float* w0; const float* a0; int M;
    __device__ __forceinline__ void operator()(const f32x4 (&acc)[2][2][4][2], const Unit& u, int wr, int wc, int fr, int fq) const {
        const int row0 = u.pm * BM + wr * 64 + fr, which = u.pn >> 3, col0 = (u.pn & 7) * BM + wc * 32 + 4 * fq;
        float* O = WAG + (size_t)which * M * DM + col0;
        f32x4 bv[2][2];
#pragma unroll
        for (int bj = 0; bj < 2; ++bj)
#pragma unroll
            for (int n = 0; n < 2; ++n) bv[bj][n] = which == 0 ? *(const f32x4*)(w0 + col0 + bj * HALF + n * 16) : (which == 1 ? *(const f32x4*)(a0 + col0 + bj * HALF + n * 16) : (f32x4){0.f, 0.f, 0.f, 0.f});
#pragma unroll
        for (int ai = 0; ai < 2; ++ai)
#pragma unroll
            for (int m = 0; m < 4; ++m) { float* rowp = O + (size_t)(row0 + ai * HALF + m * 16) * DM;
#pragma unroll
                for (int bj = 0; bj < 2; ++bj)
#pragma unroll
                    for (int n = 0; n < 2; ++n) { f32x4 v = acc[ai][bj][m][n] + bv[bj][n];
                        if (which == 0) {
#pragma unroll
                            for (int j = 0; j < 4; ++j) v[j] = __expf(-0.6065306597126334f * fast_sigmoid(v[j])); }
                        else if (which == 1) {
#pragma unroll
                            for (int j = 0; j < 4; ++j) v[j] = fast_sigmoid(v[j]); }
                        *(f32x4*)(rowp + bj * HALF + n * 16) = v; } }
    }
};

template <class Epi, class Sched, bool ALIGN_EPI = false, bool SP2 = false>
__device__ __forceinline__ void gemm_phase(PG8_LAS unsigned char* lds, const Gemm g, const Sched& S, const Epi& E, const int wid  ) {
    const int lane = fresh_lane(), tid = wid * 64 + lane, wr = wid >> 2, wc = wid & 3, fr = lane & 15, fq = lane >> 4;
    const int K = g.K, nt = K / BK;
    unsigned voffA[2], voffB[2];
#pragma unroll
    for (int i = 0; i < 2; ++i) { int R, C; stage_rc(tid * 16 + i * 8192, R, C); const int Rb = Epi::PERM ? ((R & ~31) + perm32(R & 31)) : R;
        voffA[i] = (unsigned)(R * K + C) * 2u; voffB[i] = (unsigned)(Rb * K + C) * 2u; }
    const size_t kstep = (size_t)(BK * 2);
    const size_t hstep = (size_t)HALF * K * 2;
    const size_t tstep = 2 * hstep;
    const unsigned ldsw = (unsigned)wid * 1024u;
    const int aoff = lds_byte(wr * 64 + fr, fq * 8), boff = lds_byte(wc * 32 + fr, fq * 8);
#define PG8_SA(b, h) (((b) * 2 + (h)) * HTB)
#define PG8_SB(b, h) ((4 + (b) * 2 + (h)) * HTB)
#define PG8_STAGE(bufoff, gbase, voff) do { _Pragma("unroll") for (int _i = 0; _i < 2; ++_i) \
        __builtin_amdgcn_global_load_lds((const unsigned*)((const char*)(gbase) + (voff)[_i]), (PG8_LAS unsigned*)(lds + (bufoff) + ldsw + _i * 8192), 16, 0, 0); } while (0)
#define PG8_LDA(dst, b, h) do { _Pragma("unroll") for (int m = 0; m < 4; ++m) _Pragma("unroll") for (int k = 0; k < 2; ++k) dst[m][k] = *(const PG8_LAS bf16x8*)(lds + PG8_SA(b, h) + aoff + m * 2048 + k * 1024); } while (0)
#define PG8_LDB(dst, b, h) do { _Pragma("unroll") for (int n = 0; n < 2; ++n) _Pragma("unroll") for (int k = 0; k < 2; ++k) dst[n][k] = *(const PG8_LAS bf16x8*)(lds + PG8_SB(b, h) + boff + n * 2048 + k * 1024); } while (0)
#define PG8_MMA(ai, bj, At, Bt) do { __builtin_amdgcn_s_setprio(1); _Pragma("unroll") for (int m = 0; m < 4; ++m) _Pragma("unroll") for (int n = 0; n < 2; ++n) _Pragma("unroll") for (int k = 0; k < 2; ++k) \
        acc[ai][bj][m][n] = __builtin_amdgcn_mfma_f32_16x16x32_bf16(Bt[n][k], At[m][k], acc[ai][bj][m][n], 0, 0, 0); __builtin_amdgcn_s_setprio(0); } while (0)
#define PG8_WAIT_V(n) asm volatile("s_waitcnt vmcnt(" #n ")" ::: "memory")
#define PG8_WAIT_L(n) asm volatile("s_waitcnt lgkmcnt(" #n ")" ::: "memory")
#define PG8_BAR __builtin_amdgcn_s_barrier()
#define PG8_SCHED __builtin_amdgcn_sched_barrier(0)
    Unit cur, nxt; int ui = 0;
    if (!S.next(0, cur)) return;
    f32x4 acc[2][2][4][2];
#pragma unroll
    for (int a = 0; a < 2; ++a)
#pragma unroll
        for (int b = 0; b < 2; ++b)
#pragma unroll
            for (int m = 0; m < 4; ++m)
#pragma unroll
                for (int n = 0; n < 2; ++n) acc[a][b][m][n] = (f32x4){0.f, 0.f, 0.f, 0.f};
    bf16x8 At[4][2], B0[2][2], B1[2][2];
    const char* cA = (const char*)g.A + (size_t)g.asel(cur.pn) * g.a_stride + (size_t)cur.pm * tstep; const char* cB = (const char*)g.Bt + (size_t)cur.pn * tstep;
    S.a_ready(cur);
    if constexpr (SP2) {
        PG8_STAGE(PG8_SB(0, 0), cB, voffB); PG8_STAGE(PG8_SB(0, 1), cB + hstep, voffB); PG8_STAGE(PG8_SA(0, 0), cA, voffA); PG8_STAGE(PG8_SA(0, 1), cA + hstep, voffA);
        if (wr == 1) PG8_BAR;
        PG8_WAIT_V(2); PG8_BAR;
        PG8_STAGE(PG8_SB(1, 0), cB + kstep, voffB); PG8_STAGE(PG8_SA(1, 0), cA + kstep, voffA); PG8_STAGE(PG8_SB(1, 1), cB + hstep + kstep, voffB);
        PG8_WAIT_V(6); PG8_BAR;
    } else {
        PG8_STAGE(PG8_SB(0, 0), cB, voffB); PG8_STAGE(PG8_SA(0, 0), cA, voffA); PG8_STAGE(PG8_SB(0, 1), cB + hstep, voffB); PG8_STAGE(PG8_SA(0, 1), cA + hstep, voffA);
        if (wr == 1) PG8_BAR;
        PG8_WAIT_V(4); PG8_BAR;
        PG8_STAGE(PG8_SB(1, 0), cB + kstep, voffB); PG8_STAGE(PG8_SA(1, 0), cA + kstep, voffA); PG8_STAGE(PG8_SB(1, 1), cB + hstep + kstep, voffB);
        PG8_WAIT_V(6); PG8_BAR;
    }
    for (;;) {
        const bool has_next = S.next(ui + 1, nxt);
        const char* nA = has_next ? (const char*)g.A + (size_t)g.asel(nxt.pn) * g.a_stride + (size_t)nxt.pm * tstep : cA; const char* nB = has_next ? (const char*)g.Bt + (size_t)nxt.pn * tstep : cB;
        for (int t = 0; t < nt; t += 2) {
            const bool last = (t == nt - 2);
            const char* a1 = cA + (size_t)(t + 1) * kstep;
            const char* a2 = last ? nA : cA + (size_t)(t + 2) * kstep; const char* b2 = last ? nB : cB + (size_t)(t + 2) * kstep;
            const char* a3 = a2 + kstep; const char* b3 = b2 + kstep;
            if (last && has_next) S.a_ready(nxt);
            if constexpr (SP2) {
            PG8_LDB(B0, 0, 0); PG8_LDB(B1, 0, 1); PG8_SCHED; PG8_LDA(At, 0, 0); PG8_STAGE(PG8_SA(1, 1), a1 + hstep, voffA);
            PG8_WAIT_V(8); PG8_WAIT_L(0); PG8_BAR; PG8_MMA(0, 0, At, B0); PG8_MMA(0, 1, At, B1); PG8_BAR; PG8_SCHED;
            PG8_LDA(At, 0, 1); PG8_STAGE(PG8_SB(0, 0), b2, voffB); PG8_STAGE(PG8_SB(0, 1), b2 + hstep, voffB); PG8_STAGE(PG8_SA(0, 0), a2, voffA);
            PG8_WAIT_V(8); PG8_WAIT_L(0); PG8_BAR; PG8_MMA(1, 0, At, B0); PG8_MMA(1, 1, At, B1); PG8_BAR; PG8_SCHED;
            PG8_LDB(B0, 1, 0); PG8_LDB(B1, 1, 1); PG8_SCHED; PG8_LDA(At, 1, 0); PG8_STAGE(PG8_SA(0, 1), a2 + hstep, voffA);
            PG8_WAIT_V(8); PG8_WAIT_L(0); PG8_BAR; PG8_MMA(0, 0, At, B0); PG8_MMA(0, 1, At, B1); PG8_BAR; PG8_SCHED;
            PG8_LDA(At, 1, 1); PG8_STAGE(PG8_SB(1, 0), b3, voffB); PG8_STAGE(PG8_SB(1, 1), b3 + hstep, voffB); PG8_STAGE(PG8_SA(1, 0), a3, voffA);
            PG8_WAIT_V(8); PG8_WAIT_L(0); PG8_BAR; PG8_MMA(1, 0, At, B0); PG8_MMA(1, 1, At, B1); PG8_BAR; PG8_SCHED;
            } else {
            PG8_LDB(B0, 0, 0); PG8_SCHED; PG8_LDA(At, 0, 0); PG8_STAGE(PG8_SA(1, 1), a1 + hstep, voffA);
            PG8_WAIT_L(8); PG8_BAR; PG8_WAIT_L(0); PG8_MMA(0, 0, At, B0); PG8_BAR; PG8_SCHED;
            PG8_LDB(B1, 0, 1); PG8_STAGE(PG8_SB(0, 0), b2, voffB);
            PG8_BAR; PG8_WAIT_L(0); PG8_MMA(0, 1, At, B1); PG8_BAR;
            PG8_LDA(At, 0, 1); PG8_STAGE(PG8_SA(0, 0), a2, voffA);
            PG8_BAR; PG8_WAIT_L(0); PG8_MMA(1, 0, At, B0); PG8_BAR; PG8_SCHED;
            PG8_STAGE(PG8_SB(0, 1), b2 + hstep, voffB);
            PG8_WAIT_V(6); PG8_BAR; PG8_MMA(1, 1, At, B1); PG8_BAR;
            PG8_LDB(B0, 1, 0); PG8_SCHED; PG8_LDA(At, 1, 0); PG8_STAGE(PG8_SA(0, 1), a2 + hstep, voffA);
            PG8_WAIT_L(8); PG8_BAR; PG8_WAIT_L(0); PG8_MMA(0, 0, At, B0); PG8_BAR; PG8_SCHED;
            PG8_LDB(B1, 1, 1); PG8_STAGE(PG8_SB(1, 0), b3, voffB);
            PG8_BAR; PG8_WAIT_L(0); PG8_MMA(0, 1, At, B1); PG8_BAR;
            PG8_LDA(At, 1, 1); PG8_STAGE(PG8_SA(1, 0), a3, voffA);
            PG8_BAR; PG8_WAIT_L(0); PG8_MMA(1, 0, At, B0); PG8_BAR; PG8_SCHED;
            PG8_STAGE(PG8_SB(1, 1), b3 + hstep, voffB);
            PG8_WAIT_V(6); PG8_BAR; PG8_MMA(1, 1, At, B1); PG8_BAR;
            }
        }
        if constexpr (ALIGN_EPI) { if (wr == 0) PG8_BAR; }
        if constexpr (!Epi::AFTER_DRAIN) { const int l2 = fresh_lane(); E(acc, cur, wr, wc, l2 & 15, l2 >> 4); S.done(cur); }
        if (!has_next) break;
#pragma unroll
        for (int a = 0; a < 2; ++a)
#pragma unroll
            for (int b = 0; b < 2; ++b)
#pragma unroll
                for (int m = 0; m < 4; ++m)
#pragma unroll
                    for (int n = 0; n < 2; ++n) acc[a][b][m][n] = (f32x4){0.f, 0.f, 0.f, 0.f};
        cur = nxt; cA = nA; cB = nB; ++ui;
        if constexpr (ALIGN_EPI) { if (wr == 1) PG8_BAR; }
    }
    PG8_WAIT_V(0);
    if constexpr (!ALIGN_EPI) { if (wr == 0) PG8_BAR; }
    PG8_BAR;
    if constexpr (Epi::AFTER_DRAIN) { E.fused(acc, cur, wr, wc, fr, fq, lds, wid, lane); S.done(cur); }
#undef PG8_SA
#undef PG8_SB
#undef PG8_STAGE
#undef PG8_LDA
#undef PG8_LDB
#undef PG8_MMA
#undef PG8_WAIT_V
#undef PG8_WAIT_L
#undef PG8_BAR
#undef PG8_SCHED
}
}

constexpr int NB = 4, SEQ = 2048, D = 2048, M = NB * SEQ, DEPTH = 4, PLE = 256, FF = 5632, NQKV = 18432;
constexpr int NWAVES = 8, NTHR = 512;
constexpr size_t MiB = 1ull << 20;
constexpr size_t WS_CTL = 0, CTL_ZERO_BYTES = 1 * MiB;
constexpr size_t WS_WQKV = 1 * MiB;
constexpr size_t WS_WAO = 145 * MiB;
constexpr size_t WS_WR1 = 161 * MiB;
constexpr size_t WS_WR2 = 188 * MiB;
constexpr size_t WS_WRO = 191 * MiB;
constexpr size_t WS_WCIN = 199 * MiB;
constexpr size_t WS_WCOUT = 223 * MiB;
constexpr size_t WS_WGU = 231 * MiB;
constexpr size_t WS_WDN = 407 * MiB;
constexpr size_t WS_WPG = 495 * MiB;
constexpr size_t WS_WPP = 527 * MiB;
constexpr size_t WS_XB = 531 * MiB;
constexpr size_t WS_SSQ = 595 * MiB;
constexpr size_t WS_PB = 597 * MiB;
constexpr size_t WS_PPO = 613 * MiB;
constexpr size_t WS_MO = 741 * MiB;
constexpr size_t WS_SCR = 773 * MiB;
constexpr size_t WS_END = 1233 * MiB;
constexpr size_t SC_QKV = 0, SC_O12 = 288 * MiB, SC_LSE = 352 * MiB;
constexpr size_t SC_GU = 0, SC_ACT = 176 * MiB;
constexpr size_t SC_MIX = 0, SC_WAG = 0, SC_RKV = 192 * MiB, SC_T1 = 384 * MiB, SC_Y = 396 * MiB;
constexpr size_t SC_BCU = 0;
constexpr int CW_BAR = 4096;

constexpr int RING_BYTES = 131072, MISC_OFF = RING_BYTES + 320, LDS_BYTES = 147456;

#define GAS __attribute__((address_space(1)))
#define LAS __attribute__((address_space(3)))
typedef unsigned short bf16;
typedef unsigned v4u __attribute__((ext_vector_type(4)));
typedef unsigned v2u __attribute__((ext_vector_type(2)));
typedef float f32x4 __attribute__((ext_vector_type(4)));
typedef float f32x16 __attribute__((ext_vector_type(16)));
typedef short bf16x8 __attribute__((ext_vector_type(8)));
typedef short s16x4 __attribute__((ext_vector_type(4)));
#define LDS_WAIT() asm volatile("s_waitcnt lgkmcnt(0)" ::: "memory")
__device__ __forceinline__ unsigned f2bf(float f) { unsigned u = __builtin_bit_cast(unsigned, f); return (u + 0x7fffu + ((u >> 16) & 1u)) >> 16; }
__device__ __forceinline__ unsigned pk2(float lo, float hi) { return f2bf(lo) | (f2bf(hi) << 16); }
__device__ __forceinline__ float bfl(unsigned w) { return __uint_as_float(w << 16); }
__device__ __forceinline__ float bfh(unsigned w) { return __uint_as_float(w & 0xffff0000u); }
__device__ __forceinline__ float wave_sum(float v) {
#pragma unroll
    for (int o = 1; o < 64; o <<= 1) v += __shfl_xor(v, o);
    return v;
}
template <int CTRL> __device__ __forceinline__ float dpp_f(float x) { return __int_as_float(__builtin_amdgcn_update_dpp(0, __float_as_int(x), CTRL, 0xF, 0xF, true)); }
__device__ __forceinline__ float red8(float x) { x += dpp_f<0xB1>(x); x += dpp_f<0x4E>(x); x += dpp_f<0x141>(x); return x; }
__device__ __forceinline__ float red16(float x) { x = red8(x); x += dpp_f<0x140>(x); return x; }

#define XB_TMO      128
#define XB_XCNT(j)  (256  + 64 * (j))
#define XB_XSUB(j)  (1280 + 64 * (j))
#define XB_XGEN(j)  (2304 + 64 * (j))
#define XB_TOP      3328
#define XB_TOPGEN   3392
#define XCD_BAR_WORDS 3456
#define XB_SPIN_CAP (1u << 18)

__device__ __forceinline__ unsigned xb_ld(unsigned* p)              { return __hip_atomic_load(p, __ATOMIC_RELAXED, __HIP_MEMORY_SCOPE_AGENT); }
__device__ __forceinline__ unsigned xb_add(unsigned* p, unsigned v) { return __hip_atomic_fetch_add(p, v, __ATOMIC_RELAXED, __HIP_MEMORY_SCOPE_AGENT); }
__device__ __forceinline__ unsigned xb_xcc_id() { return (unsigned)__builtin_amdgcn_s_getreg((3 << 11) | 20) & 0xFu; }
#define XB_SPIN(cond, bar) do { unsigned _sp = 0; while (cond) { __builtin_amdgcn_s_sleep(1); \
    if ((++_sp & 255u) == 0u) { if (xb_ld(&(bar)[XB_TMO])) break; if (_sp > XB_SPIN_CAP) { atomicAdd(&(bar)[XB_TMO], 1u); break; } } } } while (0)

struct XcdBarrier {
    unsigned* bar; unsigned x;
    volatile LAS unsigned* st;
};

__device__ __forceinline__ XcdBarrier xcd_barrier_post(unsigned* bar, volatile LAS unsigned* st) {
    XcdBarrier b; b.bar = bar; b.x = xb_xcc_id(); b.st = st;
    if (threadIdx.x == 0) (void)xb_add(&bar[XB_XCNT(b.x)], 1u);
    return b;
}
__device__ __forceinline__ void xcd_barrier_complete(unsigned* bar, unsigned x, unsigned& nloc, unsigned& nx) {
    const unsigned G = gridDim.x * gridDim.y * gridDim.z;
    unsigned sum, cnt, mine, sp = 0u;
    for (;;) {
        sum = 0u; cnt = 0u; mine = 0u;
#pragma unroll
        for (unsigned j = 0; j < 16; ++j) { const unsigned c = xb_ld(&bar[XB_XCNT(j)]); sum += c; cnt += (c > 0u) ? 1u : 0u; mine = (j == x) ? c : mine; }
        if (sum == G) break;
        __builtin_amdgcn_s_sleep(1);
        if ((++sp & 255u) == 0u) { if (xb_ld(&bar[XB_TMO])) break; if (sp > XB_SPIN_CAP) { atomicAdd(&bar[XB_TMO], 1u); break; } }
    }
    nloc = mine > 0u ? mine : 1u; nx = cnt > 0u ? cnt : 1u;
}

__device__ __forceinline__ void xcd_barrier(const XcdBarrier& b) {
    asm volatile("s_waitcnt vmcnt(0)" ::: "memory");
    __syncthreads();
    if (threadIdx.x == 0) {
        unsigned* bar = b.bar;
        __builtin_amdgcn_s_waitcnt(0);
        unsigned nloc = b.st[0], nx = b.st[1];
        if (nloc == 0u) { xcd_barrier_complete(bar, b.x, nloc, nx); b.st[0] = nloc; b.st[1] = nx; }
        const unsigned old = xb_add(&bar[XB_XSUB(b.x)], 1u);
        const unsigned gen = old / nloc;
        if (old + 1u == (gen + 1u) * nloc) {
            __builtin_amdgcn_fence(__ATOMIC_RELEASE, "agent");
            asm volatile("s_waitcnt vmcnt(0)" ::: "memory");
            const unsigned og = xb_add(&bar[XB_TOP], 1u);
            const unsigned tg = og / nx;
            if (og + 1u == (tg + 1u) * nx) xb_add(&bar[XB_TOPGEN], 1u);
            else XB_SPIN(xb_ld(&bar[XB_TOPGEN]) == tg, bar);
            __builtin_amdgcn_fence(__ATOMIC_ACQUIRE, "agent");
            xb_add(&bar[XB_XGEN(b.x)], 1u);
            asm volatile("s_waitcnt vmcnt(0)" ::: "memory");
        } else {
            XB_SPIN(xb_ld(&bar[XB_XGEN(b.x)]) == gen, bar);
            __builtin_amdgcn_fence(__ATOMIC_ACQUIRE, "agent");
            asm volatile("s_waitcnt vmcnt(0)" ::: "memory");
        }
    }
    __syncthreads();
}


struct Params { const float* in[35]; float* out; unsigned char* wsp; int lo, hi; };
struct Frame {
    LAS unsigned char* lds;
    int tid, lane;
    int wave;
    int vcu, G;
    __device__ __forceinline__ void ids() { lane = fresh_lane(); tid = wave * 64 + lane; }
};
constexpr int PTR_OFF = RING_BYTES + 1024;
__device__ __forceinline__ const float* in_ptr(const Frame& F, int idx) {
    const LAS unsigned* p = (const LAS unsigned*)(F.lds + PTR_OFF) + 2 * idx; const unsigned lo = __builtin_amdgcn_readfirstlane(p[0]), hi = __builtin_amdgcn_readfirstlane(p[1]);
    return (const float*)(const GAS float*)(size_t)(((unsigned long long)hi << 32) | lo); }
#define T_OUT 35
#define T_WS 36
enum { I_X = 0, I_P, I_ATTN_NORM, I_ATTN_WQKV, I_ATTN_WO, I_RWKV_NORM, I_RWKV_MU, I_RWKV_WRKV, I_RWKV_W0, I_RWKV_WW1, I_RWKV_WW2, I_RWKV_A0, I_RWKV_WA1, I_RWKV_WA2, I_RWKV_WG1, I_RWKV_WG2,
       I_RWKV_KK, I_RWKV_KA, I_RWKV_RK, I_RWKV_LNG, I_RWKV_LNB, I_RWKV_WO, I_CONV_NORM, I_CONV_WIN, I_CONV_W, I_CONV_WOUT, I_FFN_NORM, I_FFN_WGU, I_FFN_CONVW, I_FFN_CONVB, I_FFN_WDOWN,
       I_PLE_WPROJ, I_PLE_NORM, I_PLE_WGATE, I_FINAL_NORM };

struct MatI { int in_idx; long long src_off; int gain_idx; int gain_off; long long dst_off; int K, N, Kp, Np; };
#define MAT(ii, so, gi, go, dof, K_, N_, Kp_, Np_) { ii, (long long)(so), gi, go, (long long)(dof), K_, N_, Kp_, Np_ }
__device__ const MatI kMats[] = {
    MAT(I_ATTN_WQKV, 0, I_ATTN_NORM, 0, WS_WQKV, D, NQKV, D, NQKV),
    MAT(I_ATTN_WQKV, (long long)D * NQKV, I_ATTN_NORM, D, WS_WQKV + 72 * MiB, D, NQKV, D, NQKV),
    MAT(I_ATTN_WO, 0, -1, 0, WS_WAO, D, D, D, D),
    MAT(I_ATTN_WO, (long long)D * D, -1, 0, WS_WAO + 8 * MiB, D, D, D, D),
    MAT(I_RWKV_WRKV, 0, -1, 0, WS_WR1, D, D, D, D),
    MAT(I_RWKV_WRKV, (long long)D * D, -1, 0, WS_WR1 + (size_t)2048 * D * 2, D, D, D, D),
    MAT(I_RWKV_WRKV, 2ll * D * D, -1, 0, WS_WR1 + (size_t)4096 * D * 2, D, D, D, D),
    MAT(I_RWKV_WW1, 0, -1, 0, WS_WR1 + (size_t)6144 * D * 2, D, 96, D, 256),
    MAT(I_RWKV_WA1, 0, -1, 0, WS_WR1 + (size_t)6400 * D * 2, D, 96, D, 256),
    MAT(I_RWKV_WG1, 0, -1, 0, WS_WR1 + (size_t)6656 * D * 2, D, 256, D, 256),
    MAT(I_RWKV_WW2, 0, -1, 0, WS_WR2, 96, D, 256, D),
    MAT(I_RWKV_WA2, 0, -1, 0, WS_WR2 + (size_t)2048 * 256 * 2, 96, D, 256, D),
    MAT(I_RWKV_WG2, 0, -1, 0, WS_WR2 + (size_t)4096 * 256 * 2, 256, D, 256, D),
    MAT(I_RWKV_WO, 0, -1, 0, WS_WRO, D, D, D, D),
    MAT(I_CONV_WIN, 0, I_CONV_NORM, 0, WS_WCIN, D, 3 * D, D, 3 * D),
    MAT(I_CONV_WOUT, 0, -1, 0, WS_WCOUT, D, D, D, D),
    MAT(I_FFN_WGU, 0ll * D * 2 * FF, I_FFN_NORM, 0 * D, WS_WGU + 0 * 44 * MiB, D, 2 * FF, D, 2 * FF),
    MAT(I_FFN_WGU, 1ll * D * 2 * FF, I_FFN_NORM, 1 * D, WS_WGU + 1 * 44 * MiB, D, 2 * FF, D, 2 * FF),
    MAT(I_FFN_WGU, 2ll * D * 2 * FF, I_FFN_NORM, 2 * D, WS_WGU + 2 * 44 * MiB, D, 2 * FF, D, 2 * FF),
    MAT(I_FFN_WGU, 3ll * D * 2 * FF, I_FFN_NORM, 3 * D, WS_WGU + 3 * 44 * MiB, D, 2 * FF, D, 2 * FF),
    MAT(I_FFN_WDOWN, 0ll * FF * D, -1, 0, WS_WDN + 0 * 22 * MiB, FF, D, FF, D),
    MAT(I_FFN_WDOWN, 1ll * FF * D, -1, 0, WS_WDN + 1 * 22 * MiB, FF, D, FF, D),
    MAT(I_FFN_WDOWN, 2ll * FF * D, -1, 0, WS_WDN + 2 * 22 * MiB, FF, D, FF, D),
    MAT(I_FFN_WDOWN, 3ll * FF * D, -1, 0, WS_WDN + 3 * 22 * MiB, FF, D, FF, D),
    MAT(I_PLE_WGATE, 0ll * D * D, I_PLE_NORM, 0 * D, WS_WPG + 0 * 8 * MiB, D, D, D, D),
    MAT(I_PLE_WGATE, 1ll * D * D, I_PLE_NORM, 1 * D, WS_WPG + 1 * 8 * MiB, D, D, D, D),
    MAT(I_PLE_WGATE, 2ll * D * D, I_PLE_NORM, 2 * D, WS_WPG + 2 * 8 * MiB, D, D, D, D),
    MAT(I_PLE_WGATE, 3ll * D * D, I_PLE_NORM, 3 * D, WS_WPG + 3 * 8 * MiB, D, D, D, D),
    MAT(I_PLE_WPROJ, 0ll * PLE * D, -1, 0, WS_WPP + 0 * MiB, PLE, D, PLE, D),
    MAT(I_PLE_WPROJ, 1ll * PLE * D, -1, 0, WS_WPP + 1 * MiB, PLE, D, PLE, D),
    MAT(I_PLE_WPROJ, 2ll * PLE * D, -1, 0, WS_WPP + 2 * MiB, PLE, D, PLE, D),
    MAT(I_PLE_WPROJ, 3ll * PLE * D, -1, 0, WS_WPP + 3 * MiB, PLE, D, PLE, D),
};
constexpr int NMAT = sizeof(kMats) / sizeof(kMats[0]);

__device__ __forceinline__ void conv_item(const float* W, const float* gain, int K, int N, int Kp, int Np, bf16* WT, LAS float* scr, int item, int lane) {
    const int nblk = Np / 32, kb = item / nblk, nb = item % nblk, k0 = 64 * kb, n0 = 32 * nb;
    const int n = n0 + (lane & 31);
#pragma unroll 8
    for (int i = 0; i < 32; ++i) { const int kk = 2 * i + (lane >> 5), k = k0 + kk; float v = 0.f;
        if (k < K && n < N) { v = W[(size_t)k * N + n]; if (gain) v *= gain[k]; }
        scr[kk * 33 + (lane & 31)] = v; }
    LDS_WAIT(); asm volatile("" ::: "memory");
    const int c = lane & 7;
#pragma unroll
    for (int j = 0; j < 4; ++j) { const int nn = (lane >> 3) + 8 * j; const LAS float* s = scr + (8 * c) * 33 + nn;
        v4u o; o.x = pk2(s[0 * 33], s[1 * 33]); o.y = pk2(s[2 * 33], s[3 * 33]); o.z = pk2(s[4 * 33], s[5 * 33]); o.w = pk2(s[6 * 33], s[7 * 33]);
        *(GAS v4u*)(WT + (size_t)(n0 + nn) * Kp + k0 + 8 * c) = o; }
    LDS_WAIT(); asm volatile("" ::: "memory");
}

__device__ __forceinline__ void p_prologue(Frame& F) {
    F.ids();
    unsigned char* const ws_ = (unsigned char*)in_ptr(F, T_WS);
    LAS float* scr = (LAS float*)(F.lds + F.wave * 16384);
    const int gw = F.vcu * NWAVES + F.wave, NGW = F.G * NWAVES;
    int it = gw, base = 0;
    for (int mi = 0; mi < NMAT; ++mi) {
        const MatI mt = kMats[mi]; const int cnt = (mt.Kp / 64) * (mt.Np / 32);
        const float* src = in_ptr(F, mt.in_idx) + mt.src_off; const float* gain = mt.gain_idx >= 0 ? in_ptr(F, mt.gain_idx) + mt.gain_off : nullptr; bf16* dst = (bf16*)(ws_ + mt.dst_off);
        while (it < base + cnt) { conv_item(src, gain, mt.K, mt.N, mt.Kp, mt.Np, dst, scr, it - base, F.lane); it += NGW; }
        base += cnt;
    }
    const float* x = in_ptr(F, I_X); bf16* xb = (bf16*)(ws_ + WS_XB); float* ssq = (float*)(ws_ + WS_SSQ);
    for (int m = gw; m < M; m += NGW) {
        const GAS f32x4* xr = (const GAS f32x4*)(x + (size_t)m * D) + F.lane; GAS v2u* o8 = (GAS v2u*)(xb + (size_t)m * D) + F.lane; float s = 0.f;
#pragma unroll
        for (int j = 0; j < 8; ++j) { const f32x4 v = xr[64 * j]; s += (v[0] * v[0] + v[1] * v[1]) + (v[2] * v[2] + v[3] * v[3]); v2u w; w.x = pk2(v[0], v[1]); w.y = pk2(v[2], v[3]); o8[64 * j] = w; }
        s = wave_sum(s);
        if (F.lane < 32) ssq[(size_t)m * 32 + F.lane] = F.lane == 0 ? s : 0.f;
    }
    const GAS f32x4* p4 = (const GAS f32x4*)in_ptr(F, I_P); GAS v2u* pb = (GAS v2u*)(ws_ + WS_PB);
    for (size_t i = (size_t)F.vcu * NTHR + F.tid; i < (size_t)DEPTH * M * PLE / 4; i += (size_t)F.G * NTHR) { const f32x4 v = p4[i]; v2u w; w.x = pk2(v[0], v[1]); w.y = pk2(v[2], v[3]); pb[i] = w; }
}

__device__ __forceinline__ int tokrow(int b, int v, int Lsh) { return b * SEQ + ((v & ((1 << Lsh) - 1)) << (11 - Lsh)) + (v >> Lsh); }
template <int OFF> __device__ __forceinline__ s16x4 tr_read(unsigned a) { s16x4 r; asm volatile("ds_read_b64_tr_b16 %0, %1 offset:%2" : "=&v"(r) : "v"(a), "i"(OFF) : "memory"); return r; }
constexpr int VROW = 320;

template <bool COMBINE>
__device__ __forceinline__ void attn_phase(Frame& F, const bf16* QKV, bf16* O12, float* LSE, bf16* MO) {
    F.ids();
    const unsigned ldsb = (unsigned)(size_t)F.lds;
    const int nunits = COMBINE ? NB * 16 * 8 : NB * 2 * 16 * 8;
    for (int u = F.vcu; u < nunits; u += F.G) {
        F.ids();
        const int lane = F.lane, ql = lane & 31, hh = lane >> 5;
        const int qblk = u & 7, h = (u >> 3) & 15, rest = u >> 7;
        const int gg = COMBINE ? 0 : 1 + (rest & 1), b = COMBINE ? rest : (rest >> 1);
        const int Lsh = gg == 0 ? 11 : (gg == 1 ? 9 : 7);
        const int q0 = qblk * 256, cs0 = (q0 >> Lsh) << Lsh, kv0 = (q0 - 128) > cs0 ? (q0 - 128) : cs0;
        const bf16* Qp = QKV + (size_t)gg * 6144 + h * 128; const bf16* Kp = Qp + 2048; const bf16* Vp = Qp + 4096;
        __syncthreads();
        for (int i = F.tid; i < (q0 + 256 - kv0) * 16; i += NTHR) { const int v = kv0 + (i >> 4), ch = i & 15;
            const v4u val = *(const GAS v4u*)(Vp + (size_t)tokrow(b, v, Lsh) * NQKV + ch * 8);
            *(LAS v4u*)(F.lds + (v - (q0 - 128)) * VROW + ch * 16) = val; }
        __syncthreads();
        const int qw0 = q0 + 32 * F.wave, cs = (qw0 >> Lsh) << Lsh;
        const int qrow = tokrow(b, qw0 + ql, Lsh);
        bf16x8 qf[8];
#pragma unroll
        for (int s = 0; s < 8; ++s) qf[s] = *(const GAS bf16x8*)(Qp + (size_t)qrow * NQKV + 16 * s + 8 * hh);
        f32x16 S[5];
#define LOADK(dst, kb_) do { const int ks_ = qw0 - 128 + 32 * (kb_); if (ks_ >= cs) { const bf16* kp_ = Kp + (size_t)tokrow(b, ks_ + ql, Lsh) * NQKV + 8 * hh; \
        _Pragma("unroll") for (int s_ = 0; s_ < 8; ++s_) dst[s_] = *(const GAS bf16x8*)(kp_ + 16 * s_); } } while (0)
#define QKBLK(kf_, kb_) do { _Pragma("unroll") for (int r_ = 0; r_ < 16; ++r_) S[kb_][r_] = 0.f; \
        if ((qw0 - 128 + 32 * (kb_)) >= cs) { _Pragma("unroll") for (int s_ = 0; s_ < 8; ++s_) S[kb_] = __builtin_amdgcn_mfma_f32_32x32x16_bf16(kf_[s_], qf[s_], S[kb_], 0, 0, 0); } \
        __builtin_amdgcn_sched_barrier(0); } while (0)
        {
            bf16x8 ka[8], kbf[8];
#pragma unroll
            for (int s_ = 0; s_ < 8; ++s_) { ka[s_] = (bf16x8){0, 0, 0, 0, 0, 0, 0, 0}; kbf[s_] = ka[s_]; }
            LOADK(ka, 0); __builtin_amdgcn_sched_barrier(0);
            LOADK(kbf, 1); QKBLK(ka, 0);
            LOADK(ka, 2); QKBLK(kbf, 1);
            LOADK(kbf, 3); QKBLK(ka, 2);
            LOADK(ka, 4); QKBLK(kbf, 3);
            QKBLK(ka, 4);
        }
#undef LOADK
#undef QKBLK
        const float c1 = 0.08838834764831845f * 1.4426950408889634f;
        const float sl2 = exp2f(-8.0f * (float)(gg * 16 + h + 1) / 48.0f) * (float)(1 << (11 - Lsh)) * 1.4426950408889634f;
        const float lb = -sl2 * (float)(ql - 4 * hh);
        float mx = -3.0e38f;
#pragma unroll
        for (int kb = 0; kb < 5; ++kb) { const bool live = (qw0 - 128 + 32 * kb) >= cs;
#pragma unroll
            for (int r = 0; r < 16; ++r) { const int cr = (r & 3) + 8 * (r >> 2);
                float sc = S[kb][r] * c1 + (sl2 * (float)(cr - 128 + 32 * kb) + lb);
                if (kb == 0) sc = (cr + 4 * hh >= ql) ? sc : -1.0e30f;
                if (kb == 4) sc = (cr + 4 * hh <= ql) ? sc : -1.0e30f;
                sc = live ? sc : -1.0e30f;
                S[kb][r] = sc; mx = fmaxf(mx, sc); } }
        mx = fmaxf(mx, __shfl_xor(mx, 32));
        float l = 0.f;
#pragma unroll
        for (int kb = 0; kb < 5; ++kb)
#pragma unroll
            for (int r = 0; r < 16; ++r) { const float p = __builtin_amdgcn_exp2f(S[kb][r] - mx); S[kb][r] = p; l += p; }
        l += __shfl_xor(l, 32);
        f32x16 o[4];
#pragma unroll
        for (int c = 0; c < 4; ++c)
#pragma unroll
            for (int r = 0; r < 16; ++r) o[c][r] = 0.f;
        const unsigned va0 = ldsb + (unsigned)((4 * hh + ((lane & 15) >> 2)) * VROW + (16 * ((lane >> 4) & 1) + 4 * (lane & 3)) * 2);
#pragma unroll
        for (int kb = 0; kb < 5; ++kb) {
            if ((qw0 - 128 + 32 * kb) >= cs) {
#pragma unroll
                for (int s = 0; s < 2; ++s) {
                    const unsigned va = va0 + (unsigned)((32 * F.wave + 32 * kb + 16 * s) * VROW);
                    const s16x4 l0 = tr_read<0>(va), h0 = tr_read<8 * VROW>(va), l1 = tr_read<64>(va), h1 = tr_read<64 + 8 * VROW>(va);
                    const s16x4 l2 = tr_read<128>(va), h2 = tr_read<128 + 8 * VROW>(va), l3 = tr_read<192>(va), h3 = tr_read<192 + 8 * VROW>(va);
                    v4u pw; pw.x = pg8::cvt_pk_bf16(S[kb][8 * s + 0], S[kb][8 * s + 1]); pw.y = pg8::cvt_pk_bf16(S[kb][8 * s + 2], S[kb][8 * s + 3]);
                    pw.z = pg8::cvt_pk_bf16(S[kb][8 * s + 4], S[kb][8 * s + 5]); pw.w = pg8::cvt_pk_bf16(S[kb][8 * s + 6], S[kb][8 * s + 7]);
                    const bf16x8 pb = __builtin_bit_cast(bf16x8, pw);
                    asm volatile("s_waitcnt lgkmcnt(0)" ::: "memory"); __builtin_amdgcn_sched_barrier(0);
#define PKV(L, H) (bf16x8){L[0], L[1], L[2], L[3], H[0], H[1], H[2], H[3]}
                    o[0] = __builtin_amdgcn_mfma_f32_32x32x16_bf16(PKV(l0, h0), pb, o[0], 0, 0, 0);
                    o[1] = __builtin_amdgcn_mfma_f32_32x32x16_bf16(PKV(l1, h1), pb, o[1], 0, 0, 0);
                    o[2] = __builtin_amdgcn_mfma_f32_32x32x16_bf16(PKV(l2, h2), pb, o[2], 0, 0, 0);
                    o[3] = __builtin_amdgcn_mfma_f32_32x32x16_bf16(PKV(l3, h3), pb, o[3], 0, 0, 0);
#undef PKV
                }
            }
        }
        const float inv = 1.0f / l, lse0 = mx + __builtin_amdgcn_logf(l);
        if (!COMBINE) {
            bf16* orow = O12 + (size_t)(gg - 1) * M * D + (size_t)qrow * D + h * 128 + 4 * hh;
#pragma unroll
            for (int c = 0; c < 4; ++c)
#pragma unroll
                for (int g4 = 0; g4 < 4; ++g4) { v2u w; w.x = pg8::cvt_pk_bf16(o[c][4 * g4] * inv, o[c][4 * g4 + 1] * inv); w.y = pg8::cvt_pk_bf16(o[c][4 * g4 + 2] * inv, o[c][4 * g4 + 3] * inv);
                    *(GAS v2u*)(orow + 32 * c + 8 * g4) = w; }
            if (hh == 0) LSE[(size_t)(gg - 1) * M * 16 + (size_t)qrow * 16 + h] = lse0;
        } else {
            const float l1 = LSE[(size_t)qrow * 16 + h], l2 = LSE[(size_t)M * 16 + (size_t)qrow * 16 + h];
            const float mm = fmaxf(lse0, fmaxf(l1, l2));
            const float e0 = __builtin_amdgcn_exp2f(lse0 - mm), e1 = __builtin_amdgcn_exp2f(l1 - mm), e2 = __builtin_amdgcn_exp2f(l2 - mm);
            const float rd = 1.0f / (e0 + e1 + e2), w0 = e0 * inv * rd, w1 = e1 * rd, w2 = e2 * rd;
            const bf16* o1p = O12 + (size_t)qrow * D + h * 128 + 4 * hh; const bf16* o2p = o1p + (size_t)M * D;
            bf16* orow = MO + (size_t)qrow * D + h * 128 + 4 * hh;
#pragma unroll
            for (int c = 0; c < 4; ++c)
#pragma unroll
                for (int g4 = 0; g4 < 4; ++g4) { const v2u a = *(const GAS v2u*)(o1p + 32 * c + 8 * g4), bq = *(const GAS v2u*)(o2p + 32 * c + 8 * g4);
                    const float r0 = w0 * o[c][4 * g4] + w1 * bfl(a.x) + w2 * bfl(bq.x), r1 = w0 * o[c][4 * g4 + 1] + w1 * bfh(a.x) + w2 * bfh(bq.x);
                    const float r2 = w0 * o[c][4 * g4 + 2] + w1 * bfl(a.y) + w2 * bfl(bq.y), r3 = w0 * o[c][4 * g4 + 3] + w1 * bfh(a.y) + w2 * bfh(bq.y);
                    v2u w; w.x = pg8::cvt_pk_bf16(r0, r1); w.y = pg8::cvt_pk_bf16(r2, r3); *(GAS v2u*)(orow + 32 * c + 8 * g4) = w; }
        }
    }
    __syncthreads();
}

__device__ __forceinline__ void unpack8(const v4u w, float (&f)[8]) { f[0] = bfl(w.x); f[1] = bfh(w.x); f[2] = bfl(w.y); f[3] = bfh(w.y); f[4] = bfl(w.z); f[5] = bfh(w.z); f[6] = bfl(w.w); f[7] = bfh(w.w); }
__device__ __forceinline__ v4u pack8(const float (&f)[8]) { v4u w; w.x = pk2(f[0], f[1]); w.y = pk2(f[2], f[3]); w.z = pk2(f[4], f[5]); w.w = pk2(f[6], f[7]); return w; }
__device__ __forceinline__ void ffn_act_phase(Frame& F, const bf16* GU, bf16* ACT, const float* cw, const float* cb) {
    F.ids();
    constexpr int C8 = FF / 8;
    const size_t total = (size_t)(M / 4) * C8;
    for (size_t i = (size_t)F.vcu * NTHR + F.tid; i < total; i += (size_t)F.G * NTHR) {
        const int rg = (int)(i / C8), c8 = (int)(i % C8), r0 = rg * 4, t0 = r0 & (SEQ - 1), c = c8 * 8;
        float w0[8], w1[8], w2[8], bb[8];
#pragma unroll
        for (int j = 0; j < 8; ++j) { w0[j] = cw[c + j]; w1[j] = cw[FF + c + j]; w2[j] = cw[2 * FF + c + j]; bb[j] = cb[c + j]; }
        float g[6][8];
#pragma unroll
        for (int k = 0; k < 6; ++k) { const int t = t0 - 2 + k;
            if (t >= 0) unpack8(*(const GAS v4u*)(GU + (size_t)(r0 - 2 + k) * (2 * FF) + c), g[k]);
            else {
#pragma unroll
                for (int j = 0; j < 8; ++j) g[k][j] = 0.f; } }
#pragma unroll
        for (int k = 0; k < 4; ++k) { float up[8], o[8]; unpack8(*(const GAS v4u*)(GU + (size_t)(r0 + k) * (2 * FF) + FF + c), up);
#pragma unroll
            for (int j = 0; j < 8; ++j) { const float z = w0[j] * g[k][j] + w1[j] * g[k + 1][j] + w2[j] * g[k + 2][j] + bb[j]; o[j] = z * pg8::fast_sigmoid(z) * up[j]; }
            *(GAS v4u*)(ACT + (size_t)(r0 + k) * FF + c) = pack8(o); }
    }
}
__device__ __forceinline__ void conv_mix_phase(Frame& F, const bf16* BCU, bf16* Z, const float* cw) {
    F.ids();
    constexpr int C8 = D / 8;
    const size_t total = (size_t)(M / 4) * C8;
    for (size_t i = (size_t)F.vcu * NTHR + F.tid; i < total; i += (size_t)F.G * NTHR) {
        const int rg = (int)(i / C8), c8 = (int)(i % C8), r0 = rg * 4, t0 = r0 & (SEQ - 1), c = c8 * 8;
        float w0[8], w1[8], w2[8];
#pragma unroll
        for (int j = 0; j < 8; ++j) { w0[j] = cw[c + j]; w1[j] = cw[D + c + j]; w2[j] = cw[2 * D + c + j]; }
        float cu[6][8];
#pragma unroll
        for (int k = 0; k < 6; ++k) { const int t = t0 - 2 + k;
            if (t >= 0) { float a[8], b2[8]; const bf16* rp = BCU + (size_t)(r0 - 2 + k) * (3 * D) + c; unpack8(*(const GAS v4u*)(rp + D), a); unpack8(*(const GAS v4u*)(rp + 2 * D), b2);
#pragma unroll
                for (int j = 0; j < 8; ++j) cu[k][j] = a[j] * b2[j]; }
            else {
#pragma unroll
                for (int j = 0; j < 8; ++j) cu[k][j] = 0.f; } }
#pragma unroll
        for (int k = 0; k < 4; ++k) { float gb[8], o[8]; unpack8(*(const GAS v4u*)(BCU + (size_t)(r0 + k) * (3 * D) + c), gb);
#pragma unroll
            for (int j = 0; j < 8; ++j) o[j] = gb[j] * (w0[j] * cu[k][j] + w1[j] * cu[k + 1][j] + w2[j] * cu[k + 2][j]);
            *(GAS v4u*)(Z + (size_t)(r0 + k) * D + c) = pack8(o); }
    }
}

__device__ __forceinline__ void rwkv_mix_phase(Frame& F, const float* X, const float* ssq, const float* gn, const float* mu, bf16* MIX) {
    F.ids();
    const int gw = F.vcu * NWAVES + F.wave, NGW = F.G * NWAVES, lane = F.lane;
    for (int m = gw; m < M; m += NGW) {
        const int t = m & (SEQ - 1);
        float s1 = lane < 32 ? ssq[(size_t)m * 32 + lane] : 0.f, s0 = (lane < 32 && t > 0) ? ssq[(size_t)(m - 1) * 32 + lane] : 0.f;
        s1 = wave_sum(s1); s0 = wave_sum(s0);
        const float r1 = __builtin_amdgcn_rsqf(s1 * (1.0f / D) + 1e-6f), r0 = t > 0 ? __builtin_amdgcn_rsqf(s0 * (1.0f / D) + 1e-6f) : 0.f;
        const GAS f32x4* x1 = (const GAS f32x4*)(X + (size_t)m * D) + lane; const GAS f32x4* x0 = (const GAS f32x4*)(X + (size_t)(t > 0 ? m - 1 : m) * D) + lane;
        const GAS f32x4* g4 = (const GAS f32x4*)gn + lane; const GAS f32x4* mu4 = (const GAS f32x4*)mu + lane;
#pragma unroll 2
        for (int j = 0; j < 8; ++j) { const f32x4 gv = g4[64 * j]; const f32x4 hv = x1[64 * j] * gv * r1, hp = x0[64 * j] * gv * r0, xx = hp - hv;
#pragma unroll
            for (int i = 0; i < 6; ++i) { const f32x4 o = hv + xx * mu4[i * (D / 4) + 64 * j]; v2u w; w.x = pk2(o[0], o[1]); w.y = pk2(o[2], o[3]);
                *((GAS v2u*)(MIX + (size_t)i * M * D + (size_t)m * D) + lane + 64 * j) = w; } }
    }
}

constexpr int SC_T = 32, SC_ARR = SC_T * 64 * 4, SC_BUF = 5 * SC_ARR + SC_T * 32 * 4, SC_YOFF = 2 * SC_BUF, SC_YB = SC_T * 32 * 4;
__device__ __forceinline__ void rwkv_scan_phase(Frame& F, const float* RKV, const float* WAG, const float* k_k, const float* k_a, float* Y) {
    F.ids();
    const int tid = F.tid, lane = F.lane, wave = F.wave;
    for (int item = F.vcu; item < NB * 32 * 2; item += F.G) {
        const int half = item & 1, h = (item >> 1) & 31, b = item >> 6;
        const size_t gbase = (size_t)b * SEQ * D + h * 64;
        __syncthreads();
        if (wave >= 4) {
            const int st = tid - 256, ts = st >> 4, c4 = st & 15;
            const f32x4 kkc = *(const GAS f32x4*)(k_k + h * 64 + 4 * c4), kac = *(const GAS f32x4*)(k_a + h * 64 + 4 * c4);
            for (int ci = -1; ci < SEQ / SC_T; ++ci) {
                if (ci >= 1) {
                    const int t = st >> 3, v4 = st & 7; const LAS float* yb = (const LAS float*)(F.lds + SC_YOFF + ((ci - 1) & 1) * SC_YB);
                    *(GAS f32x4*)(Y + gbase + (size_t)((ci - 1) * SC_T + t) * D + 32 * half + 4 * v4) = *(const LAS f32x4*)(yb + t * 32 + 4 * v4);
                }
                if (ci + 1 < SEQ / SC_T) {
                    LAS unsigned char* bp = F.lds + ((ci + 1) & 1) * SC_BUF;
#pragma unroll
                    for (int ps = 0; ps < 2; ++ps) { const int tt = ts + 16 * ps; const size_t go = gbase + (size_t)((ci + 1) * SC_T + tt) * D + 4 * c4;
                        const f32x4 r4 = *(const GAS f32x4*)(RKV + go), k4 = *(const GAS f32x4*)(RKV + (size_t)M * D + go), v4 = *(const GAS f32x4*)(RKV + 2 * (size_t)M * D + go);
                        const f32x4 w4 = *(const GAS f32x4*)(WAG + go), a4 = *(const GAS f32x4*)(WAG + (size_t)M * D + go);
                        const f32x4 kr = k4 * kkc; float n2 = (kr[0] * kr[0] + kr[1] * kr[1]) + (kr[2] * kr[2] + kr[3] * kr[3]); n2 = red16(n2);
                        const float rn = 1.0f / fmaxf(sqrtf(n2), 1e-12f); const f32x4 kk = kr * rn;
                        const f32x4 kn = k4 * (1.0f + (a4 - 1.0f) * kac);
                        const int lo = tt * 64 + 4 * c4;
                        *(LAS f32x4*)(bp + 0 * SC_ARR + lo * 4) = r4; *(LAS f32x4*)(bp + 1 * SC_ARR + lo * 4) = w4; *(LAS f32x4*)(bp + 2 * SC_ARR + lo * 4) = kn;
                        *(LAS f32x4*)(bp + 3 * SC_ARR + lo * 4) = -kk; *(LAS f32x4*)(bp + 4 * SC_ARR + lo * 4) = kk * a4;
                        if ((c4 >> 3) == half) *(LAS f32x4*)(bp + 5 * SC_ARR + (tt * 32 + 4 * (c4 & 7)) * 4) = v4; }
                }
                __syncthreads();
            }
            {   const int ci = SEQ / SC_T; const int t = st >> 3, v4 = st & 7; const LAS float* yb = (const LAS float*)(F.lds + SC_YOFF + ((ci - 1) & 1) * SC_YB);
                *(GAS f32x4*)(Y + gbase + (size_t)((ci - 1) * SC_T + t) * D + 32 * half + 4 * v4) = *(const LAS f32x4*)(yb + t * 32 + 4 * v4); }
        } else {
            const int row = lane >> 3, kg = lane & 7, vr = 8 * wave + row;
            float s[8];
#pragma unroll
            for (int i = 0; i < 8; ++i) s[i] = 0.f;
            __syncthreads();
            for (int ci = 0; ci < SEQ / SC_T; ++ci) {
                const LAS unsigned char* bp = F.lds + (ci & 1) * SC_BUF; LAS float* yb = (LAS float*)(F.lds + SC_YOFF + (ci & 1) * SC_YB);
#pragma unroll 4
                for (int t = 0; t < SC_T; ++t) {
                    const int lo = (t * 64 + 8 * kg) * 4;
                    const f32x4 ra = *(const LAS f32x4*)(bp + 0 * SC_ARR + lo), rb = *(const LAS f32x4*)(bp + 0 * SC_ARR + lo + 16);
                    const f32x4 wa = *(const LAS f32x4*)(bp + 1 * SC_ARR + lo), wb = *(const LAS f32x4*)(bp + 1 * SC_ARR + lo + 16);
                    const f32x4 ka = *(const LAS f32x4*)(bp + 2 * SC_ARR + lo), kb = *(const LAS f32x4*)(bp + 2 * SC_ARR + lo + 16);
                    const f32x4 aa = *(const LAS f32x4*)(bp + 3 * SC_ARR + lo), ab = *(const LAS f32x4*)(bp + 3 * SC_ARR + lo + 16);
                    const f32x4 ba = *(const LAS f32x4*)(bp + 4 * SC_ARR + lo), bb = *(const LAS f32x4*)(bp + 4 * SC_ARR + lo + 16);
                    const float vv = *(const LAS float*)(bp + 5 * SC_ARR + (t * 32 + vr) * 4);
                    float sa = ((s[0] * aa[0] + s[1] * aa[1]) + (s[2] * aa[2] + s[3] * aa[3])) + ((s[4] * ab[0] + s[5] * ab[1]) + (s[6] * ab[2] + s[7] * ab[3]));
                    sa = red8(sa);
#pragma unroll
                    for (int i = 0; i < 4; ++i) { s[i] = s[i] * wa[i] + (sa * ba[i] + vv * ka[i]); s[4 + i] = s[4 + i] * wb[i] + (sa * bb[i] + vv * kb[i]); }
                    float y = ((s[0] * ra[0] + s[1] * ra[1]) + (s[2] * ra[2] + s[3] * ra[3])) + ((s[4] * rb[0] + s[5] * rb[1]) + (s[6] * rb[2] + s[7] * rb[3]));
                    y = red8(y);
                    if (kg == 0) yb[t * 32 + vr] = y;
                }
                __syncthreads();
            }
        }
    }
    __syncthreads();
}

__device__ __forceinline__ void rwkv_post_phase(Frame& F, const float* Y, const float* RKV, const float* WAG, const float* k_a, const float* r_k, const float* ln_g, const float* ln_b, bf16* MO) {
    F.ids();
    const int gw = F.vcu * NWAVES + F.wave, NGW = F.G * NWAVES, lane = F.lane;
    for (int it = gw; it < M * 32; it += NGW) {
        const int row = it >> 5, h = it & 31, c = h * 64 + lane; const size_t o = (size_t)row * D + c;
        const float y = Y[o], r = RKV[o], k = RKV[(size_t)M * D + o], v = RKV[2 * (size_t)M * D + o], a = WAG[(size_t)M * D + o], g = WAG[2 * (size_t)M * D + o];
        const float mean = wave_sum(y) * (1.0f / 64.0f), dy = y - mean, var = wave_sum(dy * dy) * (1.0f / 64.0f);
        const float yn = dy * __builtin_amdgcn_rsqf(var + 6.4e-4f) * ln_g[c] + ln_b[c];
        const float kn = k * (1.0f + (a - 1.0f) * k_a[c]);
        const float bonus = wave_sum(r * kn * r_k[c]) * v;
        MO[o] = (bf16)f2bf((yn + bonus) * g);
    }
}

__device__ __forceinline__ void final_norm_phase(Frame& F, float* X, const float* gn) {
    F.ids();
    const int gw = F.vcu * NWAVES + F.wave, NGW = F.G * NWAVES, lane = F.lane;
    for (int m = gw; m < M; m += NGW) {
        GAS f32x4* xr = (GAS f32x4*)(X + (size_t)m * D) + lane; const GAS f32x4* g4 = (const GAS f32x4*)gn + lane;
        f32x4 v[8]; float s = 0.f;
#pragma unroll
        for (int j = 0; j < 8; ++j) { v[j] = xr[64 * j]; s += (v[j][0] * v[j][0] + v[j][1] * v[j][1]) + (v[j][2] * v[j][2] + v[j][3] * v[j][3]); }
        const float rs = __builtin_amdgcn_rsqf(wave_sum(s) * (1.0f / D) + 1e-6f);
#pragma unroll
        for (int j = 0; j < 8; ++j) xr[64 * j] = v[j] * rs * g4[64 * j];
    }
}

constexpr int NPH = 43;
__host__ __device__ constexpr bool phase_used(int ph) {
    if (ph < 2 || ph == NPH - 1) return true;
    const int L = (ph - 2) / 10, s = (ph - 2) % 10, kind = L % 3;
    if (s >= 6) return true;
    return kind == 0 ? s < 4 : (kind == 1 ? true : s < 3);
}

#define IN(k) (lo <= (k) && (k) < hi)
#if MK_PER_PHASE
#define SEAM(k) do { } while (0)
#else
#define SEAM(k) do { if ((k) + 1 < hi) { XcdBarrier b_; b_.bar = (unsigned*)(ws + WS_CTL) + CW_BAR; b_.x = xb_xcc_id(); b_.st = (volatile LAS unsigned*)(F.lds + MISC_OFF) + 8; xcd_barrier(b_); } } while (0)
#endif
#define ws ((unsigned char*)in_ptr(F, T_WS))
#define XO ((float*)in_ptr(F, T_OUT))
#define INP(i) in_ptr(F, (i))
#define MO ((bf16*)(ws + WS_MO))
#define scr (ws + WS_SCR)
template <int L> __device__ __forceinline__ void layer_phases(Frame& F, const int lo, const int hi, const XcdBarrier& bar, const int bid) {
    constexpr int pb = 2 + 10 * L, kind = L % 3, j = L / 3, ver = 3 * L;
#define xcur ((L == 0) ? INP(I_X) : (const float*)XO)
#define XB0 ((bf16*)(ws + WS_XB))
#define SQ0 ((float*)(ws + WS_SSQ))
#define XBV(v) (XB0 + (size_t)((v) & 1) * M * D)
#define SQV(v) (SQ0 + (size_t)((v) & 1) * M * 32)
#define Wout ((const bf16*)(ws + (kind == 0 ? WS_WAO + (size_t)j * 8 * MiB : (kind == 1 ? WS_WRO : WS_WCOUT))))
    if constexpr (kind == 0) {
#define QKV ((bf16*)(scr + SC_QKV))
#define O12 ((bf16*)(scr + SC_O12))
#define LSE ((float*)(scr + SC_LSE))
        if (IN(pb + 0)) {
            pg8::Gemm g{XBV(ver), (const bf16*)(ws + WS_WQKV + (size_t)j * 72 * MiB), M, NQKV, D, 0, 1 << 30, 1 << 30};
            pg8::StaticOrder S; S.init(M, NQKV, F.G, bid);
            pg8::EpiScaleBf16<true> E{QKV, NQKV, SQV(ver), 0, 0};
            pg8::gemm_phase<pg8::EpiScaleBf16<true>, pg8::StaticOrder, true, true>(F.lds, g, S, E, F.wave);
            SEAM(pb + 0);
        }
        if (IN(pb + 1)) { attn_phase<false>(F, QKV, O12, LSE, MO); SEAM(pb + 1); }
        if (IN(pb + 2)) { attn_phase<true>(F, QKV, O12, LSE, MO); SEAM(pb + 2); }
    } else if constexpr (kind == 1) {
#define MIX ((bf16*)(scr + SC_MIX))
#define WAG ((float*)(scr + SC_WAG))
#define RKV ((float*)(scr + SC_RKV))
#define T1 ((bf16*)(scr + SC_T1))
#define YB ((float*)(scr + SC_Y))
        if (IN(pb + 0)) { rwkv_mix_phase(F, xcur, SQV(ver), INP(I_RWKV_NORM) + (size_t)j * D, INP(I_RWKV_MU) + (size_t)j * 6 * D, MIX); SEAM(pb + 0); }
        if (IN(pb + 1)) {
            pg8::Gemm g{MIX, (const bf16*)(ws + WS_WR1), M, 6912, D, (size_t)M * D * 2, 8, 24};
            pg8::StaticOrder S; S.init(M, 6912, F.G, bid);
            pg8::EpiR1 E{RKV, T1, M};
            pg8::gemm_phase<pg8::EpiR1, pg8::StaticOrder, true, true>(F.lds, g, S, E, F.wave);
            SEAM(pb + 1);
        }
        if (IN(pb + 2)) {
            pg8::Gemm g{T1, (const bf16*)(ws + WS_WR2), M, 3 * D, 256, (size_t)M * 256 * 2, 8, 1 << 30};
            pg8::StaticOrder S; S.init(M, 3 * D, F.G, bid);
            pg8::EpiR2 E{WAG, INP(I_RWKV_W0) + (size_t)j * D, INP(I_RWKV_A0) + (size_t)j * D, M};
            pg8::gemm_phase<pg8::EpiR2, pg8::StaticOrder, true, true>(F.lds, g, S, E, F.wave);
            SEAM(pb + 2);
        }
        if (IN(pb + 3)) { rwkv_scan_phase(F, RKV, WAG, INP(I_RWKV_KK) + (size_t)j * D, INP(I_RWKV_KA) + (size_t)j * D, YB); SEAM(pb + 3); }
        if (IN(pb + 4)) { rwkv_post_phase(F, YB, RKV, WAG, INP(I_RWKV_KA) + (size_t)j * D, INP(I_RWKV_RK) + (size_t)j * D, INP(I_RWKV_LNG) + (size_t)j * D, INP(I_RWKV_LNB) + (size_t)j * D, MO); SEAM(pb + 4); }
    } else {
#define BCU ((bf16*)(scr + SC_BCU))
        if (IN(pb + 0)) {
            pg8::Gemm g{XBV(ver), (const bf16*)(ws + WS_WCIN), M, 3 * D, D, 0, 1 << 30, 1 << 30};
            pg8::StaticOrder S; S.init(M, 3 * D, F.G, bid);
            pg8::EpiScaleBf16<true> E{BCU, 3 * D, SQV(ver), 0, 0};
            pg8::gemm_phase<pg8::EpiScaleBf16<true>, pg8::StaticOrder, true, true>(F.lds, g, S, E, F.wave);
            SEAM(pb + 0);
        }
        if (IN(pb + 1)) { conv_mix_phase(F, BCU, MO, INP(I_CONV_W) + (size_t)j * 3 * D); SEAM(pb + 1); }
    }
    constexpr int ps_out = pb + (kind == 0 ? 3 : (kind == 1 ? 5 : 2));
    if (IN(ps_out)) {
        pg8::Gemm g{MO, Wout, M, D, D, 0, 1 << 30, 1 << 30};
        pg8::StaticOrder S; S.init(M, D, F.G, bid);
        pg8::EpiResid E{xcur, XO, XBV(ver + 1), SQV(ver + 1)};
        pg8::gemm_phase<pg8::EpiResid, pg8::StaticOrder, true, true>(F.lds, g, S, E, F.wave);
        SEAM(ps_out);
    }
#define GU ((bf16*)(scr + SC_GU))
#define ACT ((bf16*)(scr + SC_ACT))
    if (IN(pb + 6)) {
        pg8::Gemm g{XBV(ver + 1), (const bf16*)(ws + WS_WGU + (size_t)L * 44 * MiB), M, 2 * FF, D, 0, 1 << 30, 1 << 30};
        pg8::StaticOrder S; S.init(M, 2 * FF, F.G, bid);
        pg8::EpiScaleBf16<true> E{GU, 2 * FF, SQV(ver + 1), 0, 0};
        pg8::gemm_phase<pg8::EpiScaleBf16<true>, pg8::StaticOrder, true, true>(F.lds, g, S, E, F.wave);
        SEAM(pb + 6);
    }
    if (IN(pb + 7)) { ffn_act_phase(F, GU, ACT, INP(I_FFN_CONVW) + (size_t)L * 3 * FF, INP(I_FFN_CONVB) + (size_t)L * FF); SEAM(pb + 7); }
    if (IN(pb + 8)) {
        pg8::Gemm g{ACT, (const bf16*)(ws + WS_WDN + (size_t)L * 22 * MiB), M, D, FF, 0, 1 << 30, 1 << 30};
        pg8::StaticOrder S; S.init(M, D, F.G, bid);
        pg8::EpiResid E{XO, XO, XBV(ver + 2), SQV(ver + 2)};
        pg8::gemm_phase<pg8::EpiResid, pg8::StaticOrder, true, true>(F.lds, g, S, E, F.wave);
        SEAM(pb + 8);
    }
    if (IN(pb + 9)) {
        pg8::Gemm g{XBV(ver + 2), (const bf16*)(ws + WS_WPG + (size_t)L * 8 * MiB), M, D, D, 0, 1 << 30, 1 << 30};
        pg8::StaticOrder S; S.init(M, D, F.G, bid);
        pg8::EpiPle E{SQV(ver + 2), XO, (const bf16*)(ws + WS_PPO) + (size_t)L * M * D, XO, XBV(ver + 3), SQV(ver + 3)};
        pg8::gemm_phase<pg8::EpiPle, pg8::StaticOrder, true, true>(F.lds, g, S, E, F.wave);
        SEAM(pb + 9);
    }
}

__global__ void __launch_bounds__(NTHR, 2) mega_fwd(Params P) {
    extern __shared__ __attribute__((aligned(16))) unsigned char lds_raw[];
    Frame F;
    F.lds = (LAS unsigned char*)lds_raw;
    F.wave = __builtin_amdgcn_readfirstlane((int)threadIdx.x >> 6); F.ids();
    F.G = gridDim.x; { const int bx = blockIdx.x; F.vcu = (F.G % 8 == 0) ? (bx % 8) * (F.G / 8) + bx / 8 : bx; }
    volatile LAS unsigned* MISC = (volatile LAS unsigned*)(F.lds + MISC_OFF);
    for (int u = F.tid; u < (LDS_BYTES - RING_BYTES) / 4; u += NTHR) ((LAS unsigned*)(F.lds + RING_BYTES))[u] = 0u;
    __syncthreads();
    if (F.tid == 0) {
#pragma unroll
        for (int i = 0; i < 35; ++i) ((LAS unsigned long long*)(F.lds + PTR_OFF))[i] = (unsigned long long)(size_t)P.in[i];
        ((LAS unsigned long long*)(F.lds + PTR_OFF))[T_OUT] = (unsigned long long)(size_t)P.out; ((LAS unsigned long long*)(F.lds + PTR_OFF))[T_WS] = (unsigned long long)(size_t)P.wsp; }
    __syncthreads();
    XcdBarrier bar; bar.bar = nullptr; bar.x = 0; bar.st = nullptr;
#if !MK_PER_PHASE
    (void)xcd_barrier_post((unsigned*)(P.wsp + WS_CTL) + CW_BAR, MISC + 8);
#endif
    const int lo = P.lo, hi = P.hi;
    const int bid = (int)blockIdx.x;

    if (IN(0)) { p_prologue(F); SEAM(0); }
    if (IN(1)) {
        pg8::Gemm g{(const bf16*)(ws + WS_PB), (const bf16*)(ws + WS_WPP), M, 4 * D, PLE, (size_t)M * PLE * 2, 8, 1 << 30};
        pg8::StaticOrder S; S.init(M, 4 * D, F.G, bid);
        pg8::EpiScaleBf16<false> E{(bf16*)(ws + WS_PPO), D, nullptr, D, (size_t)M * D};
        pg8::gemm_phase<pg8::EpiScaleBf16<false>, pg8::StaticOrder, true, true>(F.lds, g, S, E, F.wave);
        SEAM(1);
    }
    layer_phases<0>(F, lo, hi, bar, bid);
    layer_phases<1>(F, lo, hi, bar, bid);
    layer_phases<2>(F, lo, hi, bar, bid);
    layer_phases<3>(F, lo, hi, bar, bid);
    if (IN(NPH - 1)) final_norm_phase(F, XO, INP(I_FINAL_NORM));
#undef IN
#undef SEAM
#undef ws
#undef XO
#undef INP
#undef MO
#undef scr
#undef xcur
#undef XB0
#undef SQ0
#undef Wout
#undef QKV
#undef O12
#undef LSE
#undef MIX
#undef WAG
#undef RKV
#undef T1
#undef YB
#undef BCU
#undef GU
#undef ACT
#undef XBV
#undef SQV
}

extern "C" void kernel_launch(void* const* d_in, const int* in_sizes, int n_in, void* d_out, int out_size, void* d_ws, size_t ws_size, hipStream_t stream) {
    static int grid = 0;
    if (grid == 0) {
        if (n_in != 35 || out_size != M * D || ws_size < WS_END) { fprintf(stderr, "kernel_launch: unexpected problem: n_in %d out %d ws %zu (need %zu)\n", n_in, out_size, ws_size, (size_t)WS_END); grid = -1; return; }
        int dev = 0, cus = 0, per_cu = 0;
        if (hipGetDevice(&dev) != hipSuccess || hipDeviceGetAttribute(&cus, hipDeviceAttributeMultiprocessorCount, dev) != hipSuccess) { grid = -1; return; }
        if (hipFuncSetAttribute((const void*)mega_fwd, hipFuncAttributeMaxDynamicSharedMemorySize, LDS_BYTES) != hipSuccess) { fprintf(stderr, "kernel_launch: hipFuncSetAttribute failed\n"); grid = -1; return; }
        if (hipOccupancyMaxActiveBlocksPerMultiprocessor(&per_cu, (const void*)mega_fwd, NTHR, LDS_BYTES) != hipSuccess || per_cu < 1) fprintf(stderr, "kernel_launch: occupancy query says %d blocks per CU\n", per_cu);
        (void)hipGetLastError();
        grid = cus;
    }
    if (grid < 0) return;
    if (hipMemsetAsync((char*)d_ws + WS_CTL, 0, CTL_ZERO_BYTES, stream) != hipSuccess) return;
    Params a{};
    for (int i = 0; i < 35; ++i) a.in[i] = (const float*)d_in[i];
    a.out = (float*)d_out; a.wsp = (unsigned char*)d_ws;
#if MK_PER_PHASE
    for (int ph = 0; ph < NPH; ++ph) { if (!phase_used(ph)) continue; a.lo = ph; a.hi = ph + 1; hipLaunchKernelGGL(mega_fwd, dim3(grid), dim3(NTHR), LDS_BYTES, stream, a); }
#else
    a.lo = 0; a.hi = NPH; hipLaunchKernelGGL(mega_fwd, dim3(grid), dim3(NTHR), LDS_BYTES, stream, a);
#endif
}
```

```cpp
#include <hip/hip_runtime.h>
#include <cstdio>
#include <cstdint>
__device__ __forceinline__ int fresh_lane() { int l; asm volatile("v_mbcnt_lo_u32_b32 %0, -1, 0\n\tv_mbcnt_hi_u32_b32 %0, -1, %0" : "=v"(l)); return l; }
#ifndef PROBE_PH
#define PROBE_PH -1
#define PROBE_PH2 -1
#define PROBE_REPS 0
#endif
#ifndef MK_PER_PHASE
#define MK_PER_PHASE 0
#endif
namespace pg8 {
#define PG8_LAS __attribute__((address_space(3)))
typedef unsigned short bf16_t;
typedef short bf16x8 __attribute__((ext_vector_type(8)));
typedef float f32x4 __attribute__((ext_vector_type(4)));
typedef unsigned u32x4 __attribute__((ext_vector_type(4)));
constexpr int BM = 256, BK = 64, HALF = 128, HTB = HALF * BK * 2  , STAGE_BYTES = 8 * HTB, NXCD = 8, WGM = 8;

__host__ __device__ __forceinline__ int lds_byte(int r, int c) { const int st = (r >> 4) * 2 + (c >> 5), rr = r & 15, cc = c & 31, ob = rr * 64 + cc * 2; return st * 1024 + (ob ^ (((ob >> 9) & 1) << 5)); }
__host__ __device__ __forceinline__ void stage_rc(int b, int& R, int& C) { const int st = b / 1024, sb = b % 1024, swz = sb ^ (((sb >> 9) & 1) << 5); R = (st >> 1) * 16 + swz / 64; C = (st & 1) * 32 + (swz % 64) / 2; }
__host__ __device__ __forceinline__ int perm32(int rho) { const int n = rho >> 4, i = rho & 15; return 8 * (i >> 2) + 4 * n + (i & 3); }

struct Unit { int pm, pn; };
struct Gemm { const bf16_t* A; const bf16_t* Bt; int M, N, K; size_t a_stride; int grp, nsplit;
    __device__ __forceinline__ int asel(int pn) const { return pn < nsplit ? pn / grp : pn - nsplit + nsplit / grp; } };

struct StaticOrder {
    int nM, nN, nwg, G, c;
    __host__ __device__ void init(int M, int N, int G_, int c_) { nM = M / BM; nN = N / BM; nwg = nM * nN; G = G_; c = c_; }
    __host__ __device__ bool next(int i, Unit& u) const {
        const long L = (long)i * G + c; if (L >= nwg) return false;
        int wgid = (int)L; { const int q = nwg / NXCD, r = nwg % NXCD, xcd = wgid % NXCD, off = wgid / NXCD; wgid = (xcd < r ? xcd * (q + 1) : r * (q + 1) + (xcd - r) * q) + off; }
        const int nig = WGM * nN, gid = wgid / nig, fm = gid * WGM, gsz = (nM - fm) < WGM ? (nM - fm) : WGM;
        u.pm = fm + ((wgid % nig) % gsz); u.pn = (wgid % nig) / gsz; return true;
    }
    __device__ __forceinline__ void a_ready(const Unit&) const {}
    __device__ __forceinline__ void done(const Unit&) const {}
};

__device__ __forceinline__ unsigned cvt_pk_bf16(float lo, float hi) { unsigned r; asm volatile("v_cvt_pk_bf16_f32 %0, %1, %2" : "=v"(r) : "v"(lo), "v"(hi)); return r; }
typedef float f32x2 __attribute__((ext_vector_type(2)));
typedef unsigned u32x2 __attribute__((ext_vector_type(2)));
constexpr int DM = 2048;
constexpr int NPART = 32;
__device__ __forceinline__ float bf2f(unsigned short b) { return __uint_as_float(((unsigned)b) << 16); }
__device__ __forceinline__ float fast_sigmoid(float z) { return __builtin_amdgcn_rcpf(1.0f + __expf(-z)); }

__device__ __forceinline__ void rows_rstd(const float* ssq, int row0, int fq, float (&rs)[2][4]) {
#pragma unroll
    for (int ai = 0; ai < 2; ++ai)
#pragma unroll
        for (int m = 0; m < 4; ++m) { const f32x4* p = (const f32x4*)(ssq + (size_t)(row0 + ai * HALF + m * 16) * NPART + fq * 8); const f32x4 a = p[0], b = p[1];
            float s = ((a[0] + a[1]) + (a[2] + a[3])) + ((b[0] + b[1]) + (b[2] + b[3])); s += __shfl_xor(s, 16); s += __shfl_xor(s, 32);
            rs[ai][m] = __builtin_amdgcn_rsqf(s * (1.0f / (float)DM) + 1e-6f); }
}

template <bool SCALE> struct EpiScaleBf16 {
    static constexpr bool PERM = true, AFTER_DRAIN = false;
    bf16_t* O; int ldc; const float* ssq; int split_cols; size_t split_stride;
    __device__ __forceinline__ void operator()(const f32x4 (&acc)[2][2][4][2], const Unit& u, int wr, int wc, int fr, int fq) const {
        const int row0 = u.pm * BM + wr * 64 + fr; int colt = u.pn * BM; bf16_t* base = O;
        if (split_cols) { const int t = colt / split_cols; base += (size_t)t * split_stride; colt -= t * split_cols; }
        const int col0 = colt + wc * 32 + 8 * fq;
        float rs[2][4];
        if (SCALE) rows_rstd(ssq, row0, fq, rs);
#pragma unroll
        for (int ai = 0; ai < 2; ++ai)
#pragma unroll
            for (int m = 0; m < 4; ++m) { bf16_t* rowp = base + (size_t)(row0 + ai * HALF + m * 16) * ldc + col0; const float sc = SCALE ? rs[ai][m] : 1.0f;
#pragma unroll
                for (int bj = 0; bj < 2; ++bj) { const f32x4 v0 = acc[ai][bj][m][0] * sc, v1 = acc[ai][bj][m][1] * sc;
                    u32x4 w; w.x = cvt_pk_bf16(v0[0], v0[1]); w.y = cvt_pk_bf16(v0[2], v0[3]); w.z = cvt_pk_bf16(v1[0], v1[1]); w.w = cvt_pk_bf16(v1[2], v1[3]);
                    *(u32x4*)(rowp + bj * HALF) = w; } }
    }
};

#define EPI_STORE_X(v, o) do { *(f32x4*)(X + (o)) = (v); u32x2 w_; w_.x = cvt_pk_bf16((v)[0], (v)[1]); w_.y = cvt_pk_bf16((v)[2], (v)[3]); *(u32x2*)(XB + (o)) = w_; \
        ss += ((v)[0] * (v)[0] + (v)[1] * (v)[1]) + ((v)[2] * (v)[2] + (v)[3] * (v)[3]); } while (0)

struct EpiResid {
    static constexpr bool PERM = false, AFTER_DRAIN = false;
    const float* base; float* X; bf16_t* XB; float* SSQ;
    __device__ __forceinline__ void operator()(const f32x4 (&acc)[2][2][4][2], const Unit& u, int wr, int wc, int fr, int fq) const {
        const int row0 = u.pm * BM + wr * 64 + fr, col0 = u.pn * BM + wc * 32 + 4 * fq;
#pragma unroll
        for (int ai = 0; ai < 2; ++ai)
#pragma unroll
            for (int m = 0; m < 4; ++m) { const int r = row0 + ai * HALF + m * 16; const size_t off = (size_t)r * DM + col0; float ss = 0.f;
#pragma unroll
                for (int bj = 0; bj < 2; ++bj)
#pragma unroll
                    for (int n = 0; n < 2; ++n) { const size_t o = off + bj * HALF + n * 16; const f32x4 v = *(const f32x4*)(base + o) + acc[ai][bj][m][n]; EPI_STORE_X(v, o); }
                ss += __shfl_xor(ss, 16); ss += __shfl_xor(ss, 32);
                if (fq == 0) SSQ[(size_t)r * NPART + u.pn * 4 + wc] = ss;
                if (m & 1) asm volatile("" ::: "memory"); }
    }
};

struct EpiPle {
    static constexpr bool PERM = false, AFTER_DRAIN = false;
    const float* ssq; const float* base; const bf16_t* PP; float* X; bf16_t* XB; float* SSQ;
    __device__ __forceinline__ void operator()(const f32x4 (&acc)[2][2][4][2], const Unit& u, int wr, int wc, int fr, int fq) const {
        const int row0 = u.pm * BM + wr * 64 + fr, col0 = u.pn * BM + wc * 32 + 4 * fq;
        float rs[2][4]; rows_rstd(ssq, row0, fq, rs);
#pragma unroll
        for (int ai = 0; ai < 2; ++ai)
#pragma unroll
            for (int m = 0; m < 4; ++m) { const int r = row0 + ai * HALF + m * 16; const size_t off = (size_t)r * DM + col0; float ss = 0.f; const float sc = rs[ai][m];
#pragma unroll
                for (int bj = 0; bj < 2; ++bj)
#pragma unroll
                    for (int n = 0; n < 2; ++n) { const size_t o = off + bj * HALF + n * 16; const f32x4 xv = *(const f32x4*)(base + o); const u32x2 pw = *(const u32x2*)(PP + o); const f32x4 a = acc[ai][bj][m][n];
                        f32x4 v; v[0] = xv[0] + fast_sigmoid(a[0] * sc) * __uint_as_float(pw.x << 16); v[1] = xv[1] + fast_sigmoid(a[1] * sc) * __uint_as_float(pw.x & 0xffff0000u);
                        v[2] = xv[2] + fast_sigmoid(a[2] * sc) * __uint_as_float(pw.y << 16); v[3] = xv[3] + fast_sigmoid(a[3] * sc) * __uint_as_float(pw.y & 0xffff0000u);
                        EPI_STORE_X(v, o); }
                ss += __shfl_xor(ss, 16); ss += __shfl_xor(ss, 32);
                if (fq == 0) SSQ[(size_t)r * NPART + u.pn * 4 + wc] = ss;
                if (m & 1) asm volatile("" ::: "memory"); }
    }
};

struct EpiR1 {
    static constexpr bool PERM = false, AFTER_DRAIN = false;
    float* RKV; bf16_t* T1; int M;
    __device__ __forceinline__ void operator()(const f32x4 (&acc)[2][2][4][2], const Unit& u, int wr, int wc, int fr, int fq) const {
        const int row0 = u.pm * BM + wr * 64 + fr, cl0 = wc * 32 + 4 * fq;
        if (u.pn < 24) {
            float* O = RKV + (size_t)(u.pn >> 3) * M * DM + (u.pn & 7) * BM + cl0;
#pragma unroll
            for (int ai = 0; ai < 2; ++ai)
#pragma unroll
                for (int m = 0; m < 4; ++m) { float* rowp = O + (size_t)(row0 + ai * HALF + m * 16) * DM;
#pragma unroll
                    for (int bj = 0; bj < 2; ++bj)
#pragma unroll
                        for (int n = 0; n < 2; ++n) *(f32x4*)(rowp + bj * HALF + n * 16) = acc[ai][bj][m][n]; }
        } else {
            const int mode = u.pn - 24; bf16_t* O = T1 + (size_t)mode * M * 256 + cl0;
#pragma unroll
            for (int ai = 0; ai < 2; ++ai)
#pragma unroll
                for (int m = 0; m < 4; ++m) { bf16_t* rowp = O + (size_t)(row0 + ai * HALF + m * 16) * 256;
#pragma unroll
                    for (int bj = 0; bj < 2; ++bj)
#pragma unroll
                        for (int n = 0; n < 2; ++n) { f32x4 v = acc[ai][bj][m][n];
                            if (mode == 0) {
#pragma unroll
                                for (int j = 0; j < 4; ++j) v[j] = 1.0f - 2.0f * __builtin_amdgcn_rcpf(1.0f + __expf(2.0f * v[j])); }
                            else if (mode == 2) {
#pragma unroll
                                for (int j = 0; j < 4; ++j) v[j] = fast_sigmoid(v[j]); }
                            u32x2 w; w.x = cvt_pk_bf16(v[0], v[1]); w.y = cvt_pk_bf16(v[2], v[3]); *(u32x2*)(rowp + bj * HALF + n * 16) = w; } }
        }
    }
};

struct EpiR2 {
    static constexpr bool PERM = false, AFTER_DRAIN = false;
    float* WAG; const float* w0; const float* a0; int M;
    __device__ __forceinline__ void operator()(const f32x4 (&acc)[2][2][4][2], const Unit& u, int wr, int wc, int fr, int fq) const {
        const int row0 = u.pm * BM + wr * 64 + fr, which = u.pn >> 3, col0 = (u.pn & 7) * BM + wc * 32 + 4 * fq;
        float* O = WAG + (size_t)which * M * DM + col0;
        f32x4 bv[2][2];
#pragma unroll
        for (int bj = 0; bj < 2; ++bj)
#pragma unroll
            for (int n = 0; n < 2; ++n) bv[bj][n] = which == 0 ? *(const f32x4*)(w0 + col0 + bj * HALF + n * 16) : (which == 1 ? *(const f32x4*)(a0 + col0 + bj * HALF + n * 16) : (f32x4){0.f, 0.f, 0.f, 0.f});
#pragma unroll
        for (int ai = 0; ai < 2; ++ai)
#pragma unroll
            for (int m = 0; m < 4; ++m) { float* rowp = O + (size_t)(row0 + ai * HALF + m * 16) * DM;
#pragma unroll
                for (int bj = 0; bj < 2; ++bj)
#pragma unroll
                    for (int n = 0; n < 2; ++n) { f32x4 v = acc[ai][bj][m][n] + bv[bj][n];
                        if (which == 0) {
#pragma unroll
                            for (int j = 0; j < 4; ++j) v[j] = __expf(-0.6065306597126334f * fast_sigmoid(v[j])); }
                        else if (which == 1) {
#pragma unroll
                            for (int j = 0; j < 4; ++j) v[j] = fast_sigmoid(v[j]); }
                        *(f32x4*)(rowp + bj * HALF + n * 16) = v; } }
    }
};

template <class Epi, class Sched, bool ALIGN_EPI = false, bool SP2 = false>
__device__ __forceinline__ void gemm_phase(PG8_LAS unsigned char* lds, const Gemm g, const Sched& S, const Epi& E, const int wid  ) {
    const int lane = fresh_lane(), tid = wid * 64 + lane, wr = wid >> 2, wc = wid & 3, fr = lane & 15, fq = lane >> 4;
    const int K = g.K, nt = K / BK;
    unsigned voffA[2], voffB[2];
#pragma unroll
    for (int i = 0; i < 2; ++i) { int R, C; stage_rc(tid * 16 + i * 8192, R, C); const int Rb = Epi::PERM ? ((R & ~31) + perm32(R & 31)) : R;
        voffA[i] = (unsigned)(R * K + C) * 2u; voffB[i] = (unsigned)(Rb * K + C) * 2u; }
    const size_t kstep = (size_t)(BK * 2);
    const size_t hstep = (size_t)HALF * K * 2;
    const size_t tstep = 2 * hstep;
    const unsigned ldsw = (unsigned)wid * 1024u;
    const int aoff = lds_byte(wr * 64 + fr, fq * 8), boff = lds_byte(wc * 32 + fr, fq * 8);
#define PG8_SA(b, h) (((b) * 2 + (h)) * HTB)
#define PG8_SB(b, h) ((4 + (b) * 2 + (h)) * HTB)
#define PG8_STAGE(bufoff, gbase, voff) do { _Pragma("unroll") for (int _i = 0; _i < 2; ++_i) \
        __builtin_amdgcn_global_load_lds((const unsigned*)((const char*)(gbase) + (voff)[_i]), (PG8_LAS unsigned*)(lds + (bufoff) + ldsw + _i * 8192), 16, 0, 0); } while (0)
#define PG8_LDA(dst, b, h) do { _Pragma("unroll") for (int m = 0; m < 4; ++m) _Pragma("unroll") for (int k = 0; k < 2; ++k) dst[m][k] = *(const PG8_LAS bf16x8*)(lds + PG8_SA(b, h) + aoff + m * 2048 + k * 1024); } while (0)
#define PG8_LDB(dst, b, h) do { _Pragma("unroll") for (int n = 0; n < 2; ++n) _Pragma("unroll") for (int k = 0; k < 2; ++k) dst[n][k] = *(const PG8_LAS bf16x8*)(lds + PG8_SB(b, h) + boff + n * 2048 + k * 1024); } while (0)
#define PG8_MMA(ai, bj, At, Bt) do { __builtin_amdgcn_s_setprio(1); _Pragma("unroll") for (int m = 0; m < 4; ++m) _Pragma("unroll") for (int n = 0; n < 2; ++n) _Pragma("unroll") for (int k = 0; k < 2; ++k) \
        acc[ai][bj][m][n] = __builtin_amdgcn_mfma_f32_16x16x32_bf16(Bt[n][k], At[m][k], acc[ai][bj][m][n], 0, 0, 0); __builtin_amdgcn_s_setprio(0); } while (0)
#define PG8_WAIT_V(n) asm volatile("s_waitcnt vmcnt(" #n ")" ::: "memory")
#define PG8_WAIT_L(n) asm volatile("s_waitcnt lgkmcnt(" #n ")" ::: "memory")
#define PG8_BAR __builtin_amdgcn_s_barrier()
#define PG8_SCHED __builtin_amdgcn_sched_barrier(0)
    Unit cur, nxt; int ui = 0;
    if (!S.next(0, cur)) return;
    f32x4 acc[2][2][4][2];
#pragma unroll
    for (int a = 0; a < 2; ++a)
#pragma unroll
        for (int b = 0; b < 2; ++b)
#pragma unroll
            for (int m = 0; m < 4; ++m)
#pragma unroll
                for (int n = 0; n < 2; ++n) acc[a][b][m][n] = (f32x4){0.f, 0.f, 0.f, 0.f};
    bf16x8 At[4][2], B0[2][2], B1[2][2];
    const char* cA = (const char*)g.A + (size_t)g.asel(cur.pn) * g.a_stride + (size_t)cur.pm * tstep; const char* cB = (const char*)g.Bt + (size_t)cur.pn * tstep;
    S.a_ready(cur);
    if constexpr (SP2) {
        PG8_STAGE(PG8_SB(0, 0), cB, voffB); PG8_STAGE(PG8_SB(0, 1), cB + hstep, voffB); PG8_STAGE(PG8_SA(0, 0), cA, voffA); PG8_STAGE(PG8_SA(0, 1), cA + hstep, voffA);
        if (wr == 1) PG8_BAR;
        PG8_WAIT_V(2); PG8_BAR;
        PG8_STAGE(PG8_SB(1, 0), cB + kstep, voffB); PG8_STAGE(PG8_SA(1, 0), cA + kstep, voffA); PG8_STAGE(PG8_SB(1, 1), cB + hstep + kstep, voffB);
        PG8_WAIT_V(6); PG8_BAR;
    } else {
        PG8_STAGE(PG8_SB(0, 0), cB, voffB); PG8_STAGE(PG8_SA(0, 0), cA, voffA); PG8_STAGE(PG8_SB(0, 1), cB + hstep, voffB); PG8_STAGE(PG8_SA(0, 1), cA + hstep, voffA);
        if (wr == 1) PG8_BAR;
        PG8_WAIT_V(4); PG8_BAR;
        PG8_STAGE(PG8_SB(1, 0), cB + kstep, voffB); PG8_STAGE(PG8_SA(1, 0), cA + kstep, voffA); PG8_STAGE(PG8_SB(1, 1), cB + hstep + kstep, voffB);
        PG8_WAIT_V(6); PG8_BAR;
    }
    for (;;) {
        const bool has_next = S.next(ui + 1, nxt);
        const char* nA = has_next ? (const char*)g.A + (size_t)g.asel(nxt.pn) * g.a_stride + (size_t)nxt.pm * tstep : cA; const char* nB = has_next ? (const char*)g.Bt + (size_t)nxt.pn * tstep : cB;
        for (int t = 0; t < nt; t += 2) {
            const bool last = (t == nt - 2);
            const char* a1 = cA + (size_t)(t + 1) * kstep;
            const char* a2 = last ? nA : cA + (size_t)(t + 2) * kstep; const char* b2 = last ? nB : cB + (size_t)(t + 2) * kstep;
            const char* a3 = a2 + kstep; const char* b3 = b2 + kstep;
            if (last && has_next) S.a_ready(nxt);
            if constexpr (SP2) {
            PG8_LDB(B0, 0, 0); PG8_LDB(B1, 0, 1); PG8_SCHED; PG8_LDA(At, 0, 0); PG8_STAGE(PG8_SA(1, 1), a1 + hstep, voffA);
            PG8_WAIT_V(8); PG8_WAIT_L(0); PG8_BAR; PG8_MMA(0, 0, At, B0); PG8_MMA(0, 1, At, B1); PG8_BAR; PG8_SCHED;
            PG8_LDA(At, 0, 1); PG8_STAGE(PG8_SB(0, 0), b2, voffB); PG8_STAGE(PG8_SB(0, 1), b2 + hstep, voffB); PG8_STAGE(PG8_SA(0, 0), a2, voffA);
            PG8_WAIT_V(8); PG8_WAIT_L(0); PG8_BAR; PG8_MMA(1, 0, At, B0); PG8_MMA(1, 1, At, B1); PG8_BAR; PG8_SCHED;
            PG8_LDB(B0, 1, 0); PG8_LDB(B1, 1, 1); PG8_SCHED; PG8_LDA(At, 1, 0); PG8_STAGE(PG8_SA(0, 1), a2 + hstep, voffA);
            PG8_WAIT_V(8); PG8_WAIT_L(0); PG8_BAR; PG8_MMA(0, 0, At, B0); PG8_MMA(0, 1, At, B1); PG8_BAR; PG8_SCHED;
            PG8_LDA(At, 1, 1); PG8_STAGE(PG8_SB(1, 0), b3, voffB); PG8_STAGE(PG8_SB(1, 1), b3 + hstep, voffB); PG8_STAGE(PG8_SA(1, 0), a3, voffA);
            PG8_WAIT_V(8); PG8_WAIT_L(0); PG8_BAR; PG8_MMA(1, 0, At, B0); PG8_MMA(1, 1, At, B1); PG8_BAR; PG8_SCHED;
            } else {
            PG8_LDB(B0, 0, 0); PG8_SCHED; PG8_LDA(At, 0, 0); PG8_STAGE(PG8_SA(1, 1), a1 + hstep, voffA);
            PG8_WAIT_L(8); PG8_BAR; PG8_WAIT_L(0); PG8_MMA(0, 0, At, B0); PG8_BAR; PG8_SCHED;
            PG8_LDB(B1, 0, 1); PG8_STAGE(PG8_SB(0, 0), b2, voffB);
            PG8_BAR; PG8_WAIT_L(0); PG8_MMA(0, 1, At, B1); PG8_BAR;
            PG8_LDA(At, 0, 1); PG8_STAGE(PG8_SA(0, 0), a2, voffA);
            PG8_BAR; PG8_WAIT_L(0); PG8_MMA(1, 0, At, B0); PG8_BAR; PG8_SCHED;
            PG8_STAGE(PG8_SB(0, 1), b2 + hstep, voffB);
            PG8_WAIT_V(6); PG8_BAR; PG8_MMA(1, 1, At, B1); PG8_BAR;
            PG8_LDB(B0, 1, 0); PG8_SCHED; PG8_LDA(At, 1, 0); PG8_STAGE(PG8_SA(0, 1), a2 + hstep, voffA);
            PG8_WAIT_L(8); PG8_BAR; PG8_WAIT_L(0); PG8_MMA(0, 0, At, B0); PG8_BAR; PG8_SCHED;
            PG8_LDB(B1, 1, 1); PG8_STAGE(PG8_SB(1, 0), b3, voffB);
            PG8_BAR; PG8_WAIT_L(0); PG8_MMA(0, 1, At, B1); PG8_BAR;
            PG8_LDA(At, 1, 1); PG8_STAGE(PG8_SA(1, 0), a3, voffA);
            PG8_BAR; PG8_WAIT_L(0); PG8_MMA(1, 0, At, B0); PG8_BAR; PG8_SCHED;
            PG8_STAGE(PG8_SB(1, 1), b3 + hstep, voffB);
            PG8_WAIT_V(6); PG8_BAR; PG8_MMA(1, 1, At, B1); PG8_BAR;
            }
        }
        if constexpr (ALIGN_EPI) { if (wr == 0) PG8_BAR; }
        if constexpr (!Epi::AFTER_DRAIN) { const int l2 = fresh_lane(); E(acc, cur, wr, wc, l2 & 15, l2 >> 4); S.done(cur); }
        if (!has_next) break;
#pragma unroll
        for (int a = 0; a < 2; ++a)
#pragma unroll
            for (int b = 0; b < 2; ++b)
#pragma unroll
                for (int m = 0; m < 4; ++m)
#pragma unroll
                    for (int n = 0; n < 2; ++n) acc[a][b][m][n] = (f32x4){0.f, 0.f, 0.f, 0.f};
        cur = nxt; cA = nA; cB = nB; ++ui;
        if constexpr (ALIGN_EPI) { if (wr == 1) PG8_BAR; }
    }
    PG8_WAIT_V(0);
    if constexpr (!ALIGN_EPI) { if (wr == 0) PG8_BAR; }
    PG8_BAR;
    if constexpr (Epi::AFTER_DRAIN) { E.fused(acc, cur, wr, wc, fr, fq, lds, wid, lane); S.done(cur); }
#undef PG8_SA
#undef PG8_SB
#undef PG8_STAGE
#undef PG8_LDA
#undef PG8_LDB
#undef PG8_MMA
#undef PG8_WAIT_V
#undef PG8_WAIT_L
#undef PG8_BAR
#undef PG8_SCHED
}
}

constexpr int NB = 4, SEQ = 2048, D = 2048, M = NB * SEQ, DEPTH = 4, PLE = 256, FF = 5632, NQKV = 18432;
constexpr int NWAVES = 8, NTHR = 512;
constexpr size_t MiB = 1ull << 20;
constexpr size_t WS_CTL = 0, CTL_ZERO_BYTES = 1 * MiB;
constexpr size_t WS_WQKV = 1 * MiB;
constexpr size_t WS_WAO = 145 * MiB;
constexpr size_t WS_WR1 = 161 * MiB;
constexpr size_t WS_WR2 = 188 * MiB;
constexpr size_t WS_WRO = 191 * MiB;
constexpr size_t WS_WCIN = 199 * MiB;
constexpr size_t WS_WCOUT = 223 * MiB;
constexpr size_t WS_WGU = 231 * MiB;
constexpr size_t WS_WDN = 407 * MiB;
constexpr size_t WS_WPG = 495 * MiB;
constexpr size_t WS_WPP = 527 * MiB;
constexpr size_t WS_XB = 531 * MiB;
constexpr size_t WS_SSQ = 595 * MiB;
constexpr size_t WS_PB = 597 * MiB;
constexpr size_t WS_PPO = 613 * MiB;
constexpr size_t WS_MO = 741 * MiB;
constexpr size_t WS_SCR = 773 * MiB;
constexpr size_t WS_END = 1233 * MiB;
constexpr size_t SC_QKV = 0, SC_O12 = 288 * MiB, SC_LSE = 352 * MiB;
constexpr size_t SC_GU = 0, SC_ACT = 176 * MiB;
constexpr size_t SC_MIX = 0, SC_WAG = 0, SC_RKV = 192 * MiB, SC_T1 = 384 * MiB, SC_Y = 396 * MiB;
constexpr size_t SC_BCU = 0;
constexpr int CW_BAR = 4096;

constexpr int RING_BYTES = 131072, MISC_OFF = RING_BYTES + 320, LDS_BYTES = 147456;

#define GAS __attribute__((address_space(1)))
#define LAS __attribute__((address_space(3)))
typedef unsigned short bf16;
typedef unsigned v4u __attribute__((ext_vector_type(4)));
typedef unsigned v2u __attribute__((ext_vector_type(2)));
typedef float f32x4 __attribute__((ext_vector_type(4)));
typedef float f32x16 __attribute__((ext_vector_type(16)));
typedef short bf16x8 __attribute__((ext_vector_type(8)));
typedef short s16x4 __attribute__((ext_vector_type(4)));
#define LDS_WAIT() asm volatile("s_waitcnt lgkmcnt(0)" ::: "memory")
__device__ __forceinline__ unsigned f2bf(float f) { unsigned u = __builtin_bit_cast(unsigned, f); return (u + 0x7fffu + ((u >> 16) & 1u)) >> 16; }
__device__ __forceinline__ unsigned pk2(float lo, float hi) { return f2bf(lo) | (f2bf(hi) << 16); }
__device__ __forceinline__ float bfl(unsigned w) { return __uint_as_float(w << 16); }
__device__ __forceinline__ float bfh(unsigned w) { return __uint_as_float(w & 0xffff0000u); }
__device__ __forceinline__ float wave_sum(float v) {
#pragma unroll
    for (int o = 1; o < 64; o <<= 1) v += __shfl_xor(v, o);
    return v;
}
template <int CTRL> __device__ __forceinline__ float dpp_f(float x) { return __int_as_float(__builtin_amdgcn_update_dpp(0, __float_as_int(x), CTRL, 0xF, 0xF, true)); }
__device__ __forceinline__ float red8(float x) { x += dpp_f<0xB1>(x); x += dpp_f<0x4E>(x); x += dpp_f<0x141>(x); return x; }
__device__ __forceinline__ float red16(float x) { x = red8(x); x += dpp_f<0x140>(x); return x; }

#define XB_TMO      128
#define XB_XCNT(j)  (256  + 64 * (j))
#define XB_XSUB(j)  (1280 + 64 * (j))
#define XB_XGEN(j)  (2304 + 64 * (j))
#define XB_TOP      3328
#define XB_TOPGEN   3392
#define XCD_BAR_WORDS 3456
#define XB_SPIN_CAP (1u << 18)

__device__ __forceinline__ unsigned xb_ld(unsigned* p)              { return __hip_atomic_load(p, __ATOMIC_RELAXED, __HIP_MEMORY_SCOPE_AGENT); }
__device__ __forceinline__ unsigned xb_add(unsigned* p, unsigned v) { return __hip_atomic_fetch_add(p, v, __ATOMIC_RELAXED, __HIP_MEMORY_SCOPE_AGENT); }
__device__ __forceinline__ unsigned xb_xcc_id() { return (unsigned)__builtin_amdgcn_s_getreg((3 << 11) | 20) & 0xFu; }
#define XB_SPIN(cond, bar) do { unsigned _sp = 0; while (cond) { __builtin_amdgcn_s_sleep(1); \
    if ((++_sp & 255u) == 0u) { if (xb_ld(&(bar)[XB_TMO])) break; if (_sp > XB_SPIN_CAP) { atomicAdd(&(bar)[XB_TMO], 1u); break; } } } } while (0)

struct XcdBarrier {
    unsigned* bar; unsigned x;
    volatile LAS unsigned* st;
};

__device__ __forceinline__ XcdBarrier xcd_barrier_post(unsigned* bar, volatile LAS unsigned* st) {
    XcdBarrier b; b.bar = bar; b.x = xb_xcc_id(); b.st = st;
    if (threadIdx.x == 0) (void)xb_add(&bar[XB_XCNT(b.x)], 1u);
    return b;
}
__device__ __forceinline__ void xcd_barrier_complete(unsigned* bar, unsigned x, unsigned& nloc, unsigned& nx) {
    const unsigned G = gridDim.x * gridDim.y * gridDim.z;
    unsigned sum, cnt, mine, sp = 0u;
    for (;;) {
        sum = 0u; cnt = 0u; mine = 0u;
#pragma unroll
        for (unsigned j = 0; j < 16; ++j) { const unsigned c = xb_ld(&bar[XB_XCNT(j)]); sum += c; cnt += (c > 0u) ? 1u : 0u; mine = (j == x) ? c : mine; }
        if (sum == G) break;
        __builtin_amdgcn_s_sleep(1);
        if ((++sp & 255u) == 0u) { if (xb_ld(&bar[XB_TMO])) break; if (sp > XB_SPIN_CAP) { atomicAdd(&bar[XB_TMO], 1u); break; } }
    }
    nloc = mine > 0u ? mine : 1u; nx = cnt > 0u ? cnt : 1u;
}

__device__ __forceinline__ void xcd_barrier(const XcdBarrier& b) {
    asm volatile("s_waitcnt vmcnt(0)" ::: "memory");
    __syncthreads();
    if (threadIdx.x == 0) {
        unsigned* bar = b.bar;
        __builtin_amdgcn_s_waitcnt(0);
        unsigned nloc = b.st[0], nx = b.st[1];
        if (nloc == 0u) { xcd_barrier_complete(bar, b.x, nloc, nx); b.st[0] = nloc; b.st[1] = nx; }
        const unsigned old = xb_add(&bar[XB_XSUB(b.x)], 1u);
        const unsigned gen = old / nloc;
        if (old + 1u == (gen + 1u) * nloc) {
            __builtin_amdgcn_fence(__ATOMIC_RELEASE, "agent");
            asm volatile("s_waitcnt vmcnt(0)" ::: "memory");
            const unsigned og = xb_add(&bar[XB_TOP], 1u);
            const unsigned tg = og / nx;
            if (og + 1u == (tg + 1u) * nx) xb_add(&bar[XB_TOPGEN], 1u);
            else XB_SPIN(xb_ld(&bar[XB_TOPGEN]) == tg, bar);
            __builtin_amdgcn_fence(__ATOMIC_ACQUIRE, "agent");
            xb_add(&bar[XB_XGEN(b.x)], 1u);
            asm volatile("s_waitcnt vmcnt(0)" ::: "memory");
        } else {
            XB_SPIN(xb_ld(&bar[XB_XGEN(b.x)]) == gen, bar);
            __builtin_amdgcn_fence(__ATOMIC_ACQUIRE, "agent");
            asm volatile("s_waitcnt vmcnt(0)" ::: "memory");
        }
    }
    __syncthreads();
}


struct Params { const float* in[35]; float* out; unsigned char* wsp; int lo, hi; };
struct Frame {
    LAS unsigned char* lds;
    int tid, lane;
    int wave;
    int vcu, G;
    __device__ __forceinline__ void ids() { lane = fresh_lane(); tid = wave * 64 + lane; }
};
constexpr int PTR_OFF = RING_BYTES + 1024;
__device__ __forceinline__ const float* in_ptr(const Frame& F, int idx) {
    const LAS unsigned* p = (const LAS unsigned*)(F.lds + PTR_OFF) + 2 * idx; const unsigned lo = __builtin_amdgcn_readfirstlane(p[0]), hi = __builtin_amdgcn_readfirstlane(p[1]);
    return (const float*)(const GAS float*)(size_t)(((unsigned long long)hi << 32) | lo); }
#define T_OUT 35
#define T_WS 36
enum { I_X = 0, I_P, I_ATTN_NORM, I_ATTN_WQKV, I_ATTN_WO, I_RWKV_NORM, I_RWKV_MU, I_RWKV_WRKV, I_RWKV_W0, I_RWKV_WW1, I_RWKV_WW2, I_RWKV_A0, I_RWKV_WA1, I_RWKV_WA2, I_RWKV_WG1, I_RWKV_WG2,
       I_RWKV_KK, I_RWKV_KA, I_RWKV_RK, I_RWKV_LNG, I_RWKV_LNB, I_RWKV_WO, I_CONV_NORM, I_CONV_WIN, I_CONV_W, I_CONV_WOUT, I_FFN_NORM, I_FFN_WGU, I_FFN_CONVW, I_FFN_CONVB, I_FFN_WDOWN,
       I_PLE_WPROJ, I_PLE_NORM, I_PLE_WGATE, I_FINAL_NORM };

struct MatI { int in_idx; long long src_off; int gain_idx; int gain_off; long long dst_off; int K, N, Kp, Np; };
#define MAT(ii, so, gi, go, dof, K_, N_, Kp_, Np_) { ii, (long long)(so), gi, go, (long long)(dof), K_, N_, Kp_, Np_ }
__device__ const MatI kMats[] = {
    MAT(I_ATTN_WQKV, 0, I_ATTN_NORM, 0, WS_WQKV, D, NQKV, D, NQKV),
    MAT(I_ATTN_WQKV, (long long)D * NQKV, I_ATTN_NORM, D, WS_WQKV + 72 * MiB, D, NQKV, D, NQKV),
    MAT(I_ATTN_WO, 0, -1, 0, WS_WAO, D, D, D, D),
    MAT(I_ATTN_WO, (long long)D * D, -1, 0, WS_WAO + 8 * MiB, D, D, D, D),
    MAT(I_RWKV_WRKV, 0, -1, 0, WS_WR1, D, D, D, D),
    MAT(I_RWKV_WRKV, (long long)D * D, -1, 0, WS_WR1 + (size_t)2048 * D * 2, D, D, D, D),
    MAT(I_RWKV_WRKV, 2ll * D * D, -1, 0, WS_WR1 + (size_t)4096 * D * 2, D, D, D, D),
    MAT(I_RWKV_WW1, 0, -1, 0, WS_WR1 + (size_t)6144 * D * 2, D, 96, D, 256),
    MAT(I_RWKV_WA1, 0, -1, 0, WS_WR1 + (size_t)6400 * D * 2, D, 96, D, 256),
    MAT(I_RWKV_WG1, 0, -1, 0, WS_WR1 + (size_t)6656 * D * 2, D, 256, D, 256),
    MAT(I_RWKV_WW2, 0, -1, 0, WS_WR2, 96, D, 256, D),
    MAT(I_RWKV_WA2, 0, -1, 0, WS_WR2 + (size_t)2048 * 256 * 2, 96, D, 256, D),
    MAT(I_RWKV_WG2, 0, -1, 0, WS_WR2 + (size_t)4096 * 256 * 2, 256, D, 256, D),
    MAT(I_RWKV_WO, 0, -1, 0, WS_WRO, D, D, D, D),
    MAT(I_CONV_WIN, 0, I_CONV_NORM, 0, WS_WCIN, D, 3 * D, D, 3 * D),
    MAT(I_CONV_WOUT, 0, -1, 0, WS_WCOUT, D, D, D, D),
    MAT(I_FFN_WGU, 0ll * D * 2 * FF, I_FFN_NORM, 0 * D, WS_WGU + 0 * 44 * MiB, D, 2 * FF, D, 2 * FF),
    MAT(I_FFN_WGU, 1ll * D * 2 * FF, I_FFN_NORM, 1 * D, WS_WGU + 1 * 44 * MiB, D, 2 * FF, D, 2 * FF),
    MAT(I_FFN_WGU, 2ll * D * 2 * FF, I_FFN_NORM, 2 * D, WS_WGU + 2 * 44 * MiB, D, 2 * FF, D, 2 * FF),
    MAT(I_FFN_WGU, 3ll * D * 2 * FF, I_FFN_NORM, 3 * D, WS_WGU + 3 * 44 * MiB, D, 2 * FF, D, 2 * FF),
    MAT(I_FFN_WDOWN, 0ll * FF * D, -1, 0, WS_WDN + 0 * 22 * MiB, FF, D, FF, D),
    MAT(I_FFN_WDOWN, 1ll * FF * D, -1, 0, WS_WDN + 1 * 22 * MiB, FF, D, FF, D),
    MAT(I_FFN_WDOWN, 2ll * FF * D, -1, 0, WS_WDN + 2 * 22 * MiB, FF, D, FF, D),
    MAT(I_FFN_WDOWN, 3ll * FF * D, -1, 0, WS_WDN + 3 * 22 * MiB, FF, D, FF, D),
    MAT(I_PLE_WGATE, 0ll * D * D, I_PLE_NORM, 0 * D, WS_WPG + 0 * 8 * MiB, D, D, D, D),
    MAT(I_PLE_WGATE, 1ll * D * D, I_PLE_NORM, 1 * D, WS_WPG + 1 * 8 * MiB, D, D, D, D),
    MAT(I_PLE_WGATE, 2ll * D * D, I_PLE_NORM, 2 * D, WS_WPG + 2 * 8 * MiB, D, D, D, D),
    MAT(I_PLE_WGATE, 3ll * D * D, I_PLE_NORM, 3 * D, WS_WPG + 3 * 8 * MiB, D, D, D, D),
    MAT(I_PLE_WPROJ, 0ll * PLE * D, -1, 0, WS_WPP + 0 * MiB, PLE, D, PLE, D),
    MAT(I_PLE_WPROJ, 1ll * PLE * D, -1, 0, WS_WPP + 1 * MiB, PLE, D, PLE, D),
    MAT(I_PLE_WPROJ, 2ll * PLE * D, -1, 0, WS_WPP + 2 * MiB, PLE, D, PLE, D),
    MAT(I_PLE_WPROJ, 3ll * PLE * D, -1, 0, WS_WPP + 3 * MiB, PLE, D, PLE, D),
};
constexpr int NMAT = sizeof(kMats) / sizeof(kMats[0]);

__device__ __forceinline__ void conv_item(const float* W, const float* gain, int K, int N, int Kp, int Np, bf16* WT, LAS float* scr, int item, int lane) {
    const int nblk = Np / 64, kb = item / nblk, nb = item % nblk, k0 = 64 * kb, n0 = 64 * nb;
    const int kr = lane >> 3, n4 = lane & 7;
    f32x4 v[2][8];
#pragma unroll
    for (int hf = 0; hf < 2; ++hf)
#pragma unroll
        for (int i = 0; i < 8; ++i) { const int k = k0 + 8 * i + kr, n = n0 + 32 * hf + 4 * n4;
            v[hf][i] = (k < K && n < N) ? *(const GAS f32x4*)(W + (size_t)k * N + n) : (f32x4){0.f, 0.f, 0.f, 0.f}; }
    if (gain) {
#pragma unroll
        for (int i = 0; i < 8; ++i) { const int k = k0 + 8 * i + kr; const float g = k < K ? gain[k] : 0.f; v[0][i] *= g; v[1][i] *= g; } }
    const int c = lane & 7;
#pragma unroll
    for (int hf = 0; hf < 2; ++hf) {
#pragma unroll
        for (int i = 0; i < 8; ++i) { LAS float* d = scr + (8 * i + kr) * 33 + 4 * n4; d[0] = v[hf][i][0]; d[1] = v[hf][i][1]; d[2] = v[hf][i][2]; d[3] = v[hf][i][3]; }
        LDS_WAIT(); asm volatile("" ::: "memory");
#pragma unroll
        for (int j = 0; j < 4; ++j) { const int nn = (lane >> 3) + 8 * j; const LAS float* sp = scr + (8 * c) * 33 + nn;
            v4u o; o.x = pk2(sp[0 * 33], sp[1 * 33]); o.y = pk2(sp[2 * 33], sp[3 * 33]); o.z = pk2(sp[4 * 33], sp[5 * 33]); o.w = pk2(sp[6 * 33], sp[7 * 33]);
            *(GAS v4u*)(WT + (size_t)(n0 + 32 * hf + nn) * Kp + k0 + 8 * c) = o; }
        LDS_WAIT(); asm volatile("" ::: "memory");
    }
}

__device__ __forceinline__ void p_prologue(Frame& F) {
    F.ids();
    unsigned char* const ws_ = (unsigned char*)in_ptr(F, T_WS);
    LAS float* scr = (LAS float*)(F.lds + F.wave * 16384);
    const int gw = F.vcu * NWAVES + F.wave, NGW = F.G * NWAVES;
    int it = gw, base = 0;
    for (int mi = 0; mi < NMAT; ++mi) {
        const MatI mt = kMats[mi]; const int cnt = (mt.Kp / 64) * (mt.Np / 64);
        const float* src = in_ptr(F, mt.in_idx) + mt.src_off; const float* gain = mt.gain_idx >= 0 ? in_ptr(F, mt.gain_idx) + mt.gain_off : nullptr; bf16* dst = (bf16*)(ws_ + mt.dst_off);
        while (it < base + cnt) { conv_item(src, gain, mt.K, mt.N, mt.Kp, mt.Np, dst, scr, it - base, F.lane); it += NGW; }
        base += cnt;
    }
    const float* x = in_ptr(F, I_X); bf16* xb = (bf16*)(ws_ + WS_XB); float* ssq = (float*)(ws_ + WS_SSQ);
    for (int m = gw; m < M; m += NGW) {
        const GAS f32x4* xr = (const GAS f32x4*)(x + (size_t)m * D) + F.lane; GAS v2u* o8 = (GAS v2u*)(xb + (size_t)m * D) + F.lane; float s = 0.f;
#pragma unroll
        for (int j = 0; j < 8; ++j) { const f32x4 v = xr[64 * j]; s += (v[0] * v[0] + v[1] * v[1]) + (v[2] * v[2] + v[3] * v[3]); v2u w; w.x = pk2(v[0], v[1]); w.y = pk2(v[2], v[3]); o8[64 * j] = w; }
        s = wave_sum(s);
        if (F.lane < 32) ssq[(size_t)m * 32 + F.lane] = F.lane == 0 ? s : 0.f;
    }
    const GAS f32x4* p4 = (const GAS f32x4*)in_ptr(F, I_P); GAS v2u* pb = (GAS v2u*)(ws_ + WS_PB);
    for (size_t i = (size_t)F.vcu * NTHR + F.tid; i < (size_t)DEPTH * M * PLE / 4; i += (size_t)F.G * NTHR) { const f32x4 v = p4[i]; v2u w; w.x = pk2(v[0], v[1]); w.y = pk2(v[2], v[3]); pb[i] = w; }
}

__device__ __forceinline__ int tokrow(int b, int v, int Lsh) { return b * SEQ + ((v & ((1 << Lsh) - 1)) << (11 - Lsh)) + (v >> Lsh); }
template <int OFF> __device__ __forceinline__ s16x4 tr_read(unsigned a) { s16x4 r; asm volatile("ds_read_b64_tr_b16 %0, %1 offset:%2" : "=&v"(r) : "v"(a), "i"(OFF) : "memory"); return r; }
constexpr int VROW = 320;

template <bool COMBINE>
__device__ __forceinline__ void attn_phase(Frame& F, const bf16* QKV, bf16* O12, float* LSE, bf16* MO) {
    F.ids();
    const unsigned ldsb = (unsigned)(size_t)F.lds;
    const int nunits = COMBINE ? NB * 16 * 8 : NB * 2 * 16 * 8;
    for (int u = F.vcu; u < nunits; u += F.G) {
        F.ids();
        const int lane = F.lane, ql = lane & 31, hh = lane >> 5;
        const int qblk = u & 7, h = (u >> 3) & 15, rest = u >> 7;
        const int gg = COMBINE ? 0 : 1 + (rest & 1), b = COMBINE ? rest : (rest >> 1);
        const int Lsh = gg == 0 ? 11 : (gg == 1 ? 9 : 7);
        const int q0 = qblk * 256, cs0 = (q0 >> Lsh) << Lsh, kv0 = (q0 - 128) > cs0 ? (q0 - 128) : cs0;
        const bf16* Qp = QKV + (size_t)gg * 6144 + h * 128; const bf16* Kp = Qp + 2048; const bf16* Vp = Qp + 4096;
        __syncthreads();
        for (int i = F.tid; i < (q0 + 256 - kv0) * 16; i += NTHR) { const int v = kv0 + (i >> 4), ch = i & 15;
            const v4u val = *(const GAS v4u*)(Vp + (size_t)tokrow(b, v, Lsh) * NQKV + ch * 8);
            *(LAS v4u*)(F.lds + (v - (q0 - 128)) * VROW + ch * 16) = val; }
        __syncthreads();
        const int qw0 = q0 + 32 * F.wave, cs = (qw0 >> Lsh) << Lsh;
        const int qrow = tokrow(b, qw0 + ql, Lsh);
        bf16x8 qf[8];
#pragma unroll
        for (int s = 0; s < 8; ++s) qf[s] = *(const GAS bf16x8*)(Qp + (size_t)qrow * NQKV + 16 * s + 8 * hh);
        f32x16 S[5];
#define LOADK(dst, kb_) do { const int ks_ = qw0 - 128 + 32 * (kb_); if (ks_ >= cs) { const bf16* kp_ = Kp + (size_t)tokrow(b, ks_ + ql, Lsh) * NQKV + 8 * hh; \
        _Pragma("unroll") for (int s_ = 0; s_ < 8; ++s_) dst[s_] = *(const GAS bf16x8*)(kp_ + 16 * s_); } } while (0)
#define QKBLK(kf_, kb_) do { _Pragma("unroll") for (int r_ = 0; r_ < 16; ++r_) S[kb_][r_] = 0.f; \
        if ((qw0 - 128 + 32 * (kb_)) >= cs) { _Pragma("unroll") for (int s_ = 0; s_ < 8; ++s_) S[kb_] = __builtin_amdgcn_mfma_f32_32x32x16_bf16(kf_[s_], qf[s_], S[kb_], 0, 0, 0); } \
        __builtin_amdgcn_sched_barrier(0); } while (0)
        {
            bf16x8 ka[8], kbf[8];
#pragma unroll
            for (int s_ = 0; s_ < 8; ++s_) { ka[s_] = (bf16x8){0, 0, 0, 0, 0, 0, 0, 0}; kbf[s_] = ka[s_]; }
            LOADK(ka, 0); __builtin_amdgcn_sched_barrier(0);
            LOADK(kbf, 1); QKBLK(ka, 0);
            LOADK(ka, 2); QKBLK(kbf, 1);
            LOADK(kbf, 3); QKBLK(ka, 2);
            LOADK(ka, 4); QKBLK(kbf, 3);
            QKBLK(ka, 4);
        }
#undef LOADK
#undef QKBLK
        const float c1 = 0.08838834764831845f * 1.4426950408889634f;
        const float sl2 = exp2f(-8.0f * (float)(gg * 16 + h + 1) / 48.0f) * (float)(1 << (11 - Lsh)) * 1.4426950408889634f;
        const float lb = -sl2 * (float)(ql - 4 * hh);
        float mx = -3.0e38f;
#pragma unroll
        for (int kb = 0; kb < 5; ++kb) { const bool live = (qw0 - 128 + 32 * kb) >= cs;
#pragma unroll
            for (int r = 0; r < 16; ++r) { const int cr = (r & 3) + 8 * (r >> 2);
                float sc = S[kb][r] * c1 + (sl2 * (float)(cr - 128 + 32 * kb) + lb);
                if (kb == 0) sc = (cr + 4 * hh >= ql) ? sc : -1.0e30f;
                if (kb == 4) sc = (cr + 4 * hh <= ql) ? sc : -1.0e30f;
                sc = live ? sc : -1.0e30f;
                S[kb][r] = sc; mx = fmaxf(mx, sc); } }
        mx = fmaxf(mx, __shfl_xor(mx, 32));
        float l = 0.f;
#pragma unroll
        for (int kb = 0; kb < 5; ++kb)
#pragma unroll
            for (int r = 0; r < 16; ++r) { const float p = __builtin_amdgcn_exp2f(S[kb][r] - mx); S[kb][r] = p; l += p; }
        l += __shfl_xor(l, 32);
        f32x16 o[4];
#pragma unroll
        for (int c = 0; c < 4; ++c)
#pragma unroll
            for (int r = 0; r < 16; ++r) o[c][r] = 0.f;
        const unsigned va0 = ldsb + (unsigned)((4 * hh + ((lane & 15) >> 2)) * VROW + (16 * ((lane >> 4) & 1) + 4 * (lane & 3)) * 2);
#pragma unroll
        for (int kb = 0; kb < 5; ++kb) {
            if ((qw0 - 128 + 32 * kb) >= cs) {
#pragma unroll
                for (int s = 0; s < 2; ++s) {
                    const unsigned va = va0 + (unsigned)((32 * F.wave + 32 * kb + 16 * s) * VROW);
                    const s16x4 l0 = tr_read<0>(va), h0 = tr_read<8 * VROW>(va), l1 = tr_read<64>(va), h1 = tr_read<64 + 8 * VROW>(va);
                    const s16x4 l2 = tr_read<128>(va), h2 = tr_read<128 + 8 * VROW>(va), l3 = tr_read<192>(va), h3 = tr_read<192 + 8 * VROW>(va);
                    v4u pw; pw.x = pg8::cvt_pk_bf16(S[kb][8 * s + 0], S[kb][8 * s + 1]); pw.y = pg8::cvt_pk_bf16(S[kb][8 * s + 2], S[kb][8 * s + 3]);
                    pw.z = pg8::cvt_pk_bf16(S[kb][8 * s + 4], S[kb][8 * s + 5]); pw.w = pg8::cvt_pk_bf16(S[kb][8 * s + 6], S[kb][8 * s + 7]);
                    const bf16x8 pb = __builtin_bit_cast(bf16x8, pw);
                    asm volatile("s_waitcnt lgkmcnt(0)" ::: "memory"); __builtin_amdgcn_sched_barrier(0);
#define PKV(L, H) (bf16x8){L[0], L[1], L[2], L[3], H[0], H[1], H[2], H[3]}
                    o[0] = __builtin_amdgcn_mfma_f32_32x32x16_bf16(PKV(l0, h0), pb, o[0], 0, 0, 0);
                    o[1] = __builtin_amdgcn_mfma_f32_32x32x16_bf16(PKV(l1, h1), pb, o[1], 0, 0, 0);
                    o[2] = __builtin_amdgcn_mfma_f32_32x32x16_bf16(PKV(l2, h2), pb, o[2], 0, 0, 0);
                    o[3] = __builtin_amdgcn_mfma_f32_32x32x16_bf16(PKV(l3, h3), pb, o[3], 0, 0, 0);
#undef PKV
                }
            }
        }
        const float inv = 1.0f / l, lse0 = mx + __builtin_amdgcn_logf(l);
        if (!COMBINE) {
            bf16* orow = O12 + (size_t)(gg - 1) * M * D + (size_t)qrow * D + h * 128 + 4 * hh;
#pragma unroll
            for (int c = 0; c < 4; ++c)
#pragma unroll
                for (int g4 = 0; g4 < 4; ++g4) { v2u w; w.x = pg8::cvt_pk_bf16(o[c][4 * g4] * inv, o[c][4 * g4 + 1] * inv); w.y = pg8::cvt_pk_bf16(o[c][4 * g4 + 2] * inv, o[c][4 * g4 + 3] * inv);
                    *(GAS v2u*)(orow + 32 * c + 8 * g4) = w; }
            if (hh == 0) LSE[(size_t)(gg - 1) * M * 16 + (size_t)qrow * 16 + h] = lse0;
        } else {
            const float l1 = LSE[(size_t)qrow * 16 + h], l2 = LSE[(size_t)M * 16 + (size_t)qrow * 16 + h];
            const float mm = fmaxf(lse0, fmaxf(l1, l2));
            const float e0 = __builtin_amdgcn_exp2f(lse0 - mm), e1 = __builtin_amdgcn_exp2f(l1 - mm), e2 = __builtin_amdgcn_exp2f(l2 - mm);
            const float rd = 1.0f / (e0 + e1 + e2), w0 = e0 * inv * rd, w1 = e1 * rd, w2 = e2 * rd;
            const bf16* o1p = O12 + (size_t)qrow * D + h * 128 + 4 * hh; const bf16* o2p = o1p + (size_t)M * D;
            bf16* orow = MO + (size_t)qrow * D + h * 128 + 4 * hh;
#pragma unroll
            for (int c = 0; c < 4; ++c)
#pragma unroll
                for (int g4 = 0; g4 < 4; ++g4) { const v2u a = *(const GAS v2u*)(o1p + 32 * c + 8 * g4), bq = *(const GAS v2u*)(o2p + 32 * c + 8 * g4);
                    const float r0 = w0 * o[c][4 * g4] + w1 * bfl(a.x) + w2 * bfl(bq.x), r1 = w0 * o[c][4 * g4 + 1] + w1 * bfh(a.x) + w2 * bfh(bq.x);
                    const float r2 = w0 * o[c][4 * g4 + 2] + w1 * bfl(a.y) + w2 * bfl(bq.y), r3 = w0 * o[c][4 * g4 + 3] + w1 * bfh(a.y) + w2 * bfh(bq.y);
                    v2u w; w.x = pg8::cvt_pk_bf16(r0, r1); w.y = pg8::cvt_pk_bf16(r2, r3); *(GAS v2u*)(orow + 32 * c + 8 * g4) = w; }
        }
    }
    __syncthreads();
}

__device__ __forceinline__ void unpack8(const v4u w, float (&f)[8]) { f[0] = bfl(w.x); f[1] = bfh(w.x); f[2] = bfl(w.y); f[3] = bfh(w.y); f[4] = bfl(w.z); f[5] = bfh(w.z); f[6] = bfl(w.w); f[7] = bfh(w.w); }
__device__ __forceinline__ v4u pack8(const float (&f)[8]) { v4u w; w.x = pk2(f[0], f[1]); w.y = pk2(f[2], f[3]); w.z = pk2(f[4], f[5]); w.w = pk2(f[6], f[7]); return w; }
__device__ __forceinline__ void ffn_act_phase(Frame& F, const bf16* GU, bf16* ACT, const float* cw, const float* cb) {
    F.ids();
    constexpr int C8 = FF / 8;
    const size_t total = (size_t)(M / 4) * C8;
    for (size_t i = (size_t)F.vcu * NTHR + F.tid; i < total; i += (size_t)F.G * NTHR) {
        const int rg = (int)(i / C8), c8 = (int)(i % C8), r0 = rg * 4, t0 = r0 & (SEQ - 1), c = c8 * 8;
        float w0[8], w1[8], w2[8], bb[8];
#pragma unroll
        for (int j = 0; j < 8; ++j) { w0[j] = cw[c + j]; w1[j] = cw[FF + c + j]; w2[j] = cw[2 * FF + c + j]; bb[j] = cb[c + j]; }
        float g[6][8];
#pragma unroll
        for (int k = 0; k < 6; ++k) { const int t = t0 - 2 + k;
            if (t >= 0) unpack8(*(const GAS v4u*)(GU + (size_t)(r0 - 2 + k) * (2 * FF) + c), g[k]);
            else {
#pragma unroll
                for (int j = 0; j < 8; ++j) g[k][j] = 0.f; } }
#pragma unroll
        for (int k = 0; k < 4; ++k) { float up[8], o[8]; unpack8(*(const GAS v4u*)(GU + (size_t)(r0 + k) * (2 * FF) + FF + c), up);
#pragma unroll
            for (int j = 0; j < 8; ++j) { const float z = w0[j] * g[k][j] + w1[j] * g[k + 1][j] + w2[j] * g[k + 2][j] + bb[j]; o[j] = z * pg8::fast_sigmoid(z) * up[j]; }
            *(GAS v4u*)(ACT + (size_t)(r0 + k) * FF + c) = pack8(o); }
    }
}
__device__ __forceinline__ void conv_mix_phase(Frame& F, const bf16* BCU, bf16* Z, const float* cw) {
    F.ids();
    constexpr int C8 = D / 8;
    const size_t total = (size_t)(M / 4) * C8;
    for (size_t i = (size_t)F.vcu * NTHR + F.tid; i < total; i += (size_t)F.G * NTHR) {
        const int rg = (int)(i / C8), c8 = (int)(i % C8), r0 = rg * 4, t0 = r0 & (SEQ - 1), c = c8 * 8;
        float w0[8], w1[8], w2[8];
#pragma unroll
        for (int j = 0; j < 8; ++j) { w0[j] = cw[c + j]; w1[j] = cw[D + c + j]; w2[j] = cw[2 * D + c + j]; }
        float cu[6][8];
#pragma unroll
        for (int k = 0; k < 6; ++k) { const int t = t0 - 2 + k;
            if (t >= 0) { float a[8], b2[8]; const bf16* rp = BCU + (size_t)(r0 - 2 + k) * (3 * D) + c; unpack8(*(const GAS v4u*)(rp + D), a); unpack8(*(const GAS v4u*)(rp + 2 * D), b2);
#pragma unroll
                for (int j = 0; j < 8; ++j) cu[k][j] = a[j] * b2[j]; }
            else {
#pragma unroll
                for (int j = 0; j < 8; ++j) cu[k][j] = 0.f; } }
#pragma unroll
        for (int k = 0; k < 4; ++k) { float gb[8], o[8]; unpack8(*(const GAS v4u*)(BCU + (size_t)(r0 + k) * (3 * D) + c), gb);
#pragma unroll
            for (int j = 0; j < 8; ++j) o[j] = gb[j] * (w0[j] * cu[k][j] + w1[j] * cu[k + 1][j] + w2[j] * cu[k + 2][j]);
            *(GAS v4u*)(Z + (size_t)(r0 + k) * D + c) = pack8(o); }
    }
}

__device__ __forceinline__ void rwkv_mix_phase(Frame& F, const float* X, const float* ssq, const float* gn, const float* mu, bf16* MIX) {
    F.ids();
    const int gw = F.vcu * NWAVES + F.wave, NGW = F.G * NWAVES, lane = F.lane;
    for (int m = gw; m < M; m += NGW) {
        const int t = m & (SEQ - 1);
        float s1 = lane < 32 ? ssq[(size_t)m * 32 + lane] : 0.f, s0 = (lane < 32 && t > 0) ? ssq[(size_t)(m - 1) * 32 + lane] : 0.f;
        s1 = wave_sum(s1); s0 = wave_sum(s0);
        const float r1 = __builtin_amdgcn_rsqf(s1 * (1.0f / D) + 1e-6f), r0 = t > 0 ? __builtin_amdgcn_rsqf(s0 * (1.0f / D) + 1e-6f) : 0.f;
        const GAS f32x4* x1 = (const GAS f32x4*)(X + (size_t)m * D) + lane; const GAS f32x4* x0 = (const GAS f32x4*)(X + (size_t)(t > 0 ? m - 1 : m) * D) + lane;
        const GAS f32x4* g4 = (const GAS f32x4*)gn + lane; const GAS f32x4* mu4 = (const GAS f32x4*)mu + lane;
#pragma unroll 2
        for (int j = 0; j < 8; ++j) { const f32x4 gv = g4[64 * j]; const f32x4 hv = x1[64 * j] * gv * r1, hp = x0[64 * j] * gv * r0, xx = hp - hv;
#pragma unroll
            for (int i = 0; i < 6; ++i) { const f32x4 o = hv + xx * mu4[i * (D / 4) + 64 * j]; v2u w; w.x = pk2(o[0], o[1]); w.y = pk2(o[2], o[3]);
                *((GAS v2u*)(MIX + (size_t)i * M * D + (size_t)m * D) + lane + 64 * j) = w; } }
    }
}

constexpr int SC_T = 32, SC_ARR = SC_T * 64 * 4, SC_BUF = 5 * SC_ARR + SC_T * 32 * 4, SC_YOFF = 2 * SC_BUF, SC_YB = SC_T * 32 * 4;
__device__ __forceinline__ void rwkv_scan_phase(Frame& F, const float* RKV, const float* WAG, const float* k_k, const float* k_a, float* Y) {
    F.ids();
    const int tid = F.tid, lane = F.lane, wave = F.wave;
    for (int item = F.vcu; item < NB * 32 * 2; item += F.G) {
        const int half = item & 1, h = (item >> 1) & 31, b = item >> 6;
        const size_t gbase = (size_t)b * SEQ * D + h * 64;
        __syncthreads();
        if (wave >= 4) {
            const int st = tid - 256, ts = st >> 4, c4 = st & 15;
            const f32x4 kkc = *(const GAS f32x4*)(k_k + h * 64 + 4 * c4), kac = *(const GAS f32x4*)(k_a + h * 64 + 4 * c4);
            for (int ci = -1; ci < SEQ / SC_T; ++ci) {
                if (ci >= 1) {
                    const int t = st >> 3, v4 = st & 7; const LAS float* yb = (const LAS float*)(F.lds + SC_YOFF + ((ci - 1) & 1) * SC_YB);
                    *(GAS f32x4*)(Y + gbase + (size_t)((ci - 1) * SC_T + t) * D + 32 * half + 4 * v4) = *(const LAS f32x4*)(yb + t * 32 + 4 * v4);
                }
                if (ci + 1 < SEQ / SC_T) {
                    LAS unsigned char* bp = F.lds + ((ci + 1) & 1) * SC_BUF;
#pragma unroll
                    for (int ps = 0; ps < 2; ++ps) { const int tt = ts + 16 * ps; const size_t go = gbase + (size_t)((ci + 1) * SC_T + tt) * D + 4 * c4;
                        const f32x4 r4 = *(const GAS f32x4*)(RKV + go), k4 = *(const GAS f32x4*)(RKV + (size_t)M * D + go), v4 = *(const GAS f32x4*)(RKV + 2 * (size_t)M * D + go);
                        const f32x4 w4 = *(const GAS f32x4*)(WAG + go), a4 = *(const GAS f32x4*)(WAG + (size_t)M * D + go);
                        const f32x4 kr = k4 * kkc; float n2 = (kr[0] * kr[0] + kr[1] * kr[1]) + (kr[2] * kr[2] + kr[3] * kr[3]); n2 = red16(n2);
                        const float rn = 1.0f / fmaxf(sqrtf(n2), 1e-12f); const f32x4 kk = kr * rn;
                        const f32x4 kn = k4 * (1.0f + (a4 - 1.0f) * kac);
                        const int lo = tt * 64 + 4 * c4;
                        *(LAS f32x4*)(bp + 0 * SC_ARR + lo * 4) = r4; *(LAS f32x4*)(bp + 1 * SC_ARR + lo * 4) = w4; *(LAS f32x4*)(bp + 2 * SC_ARR + lo * 4) = kn;
                        *(LAS f32x4*)(bp + 3 * SC_ARR + lo * 4) = -kk; *(LAS f32x4*)(bp + 4 * SC_ARR + lo * 4) = kk * a4;
                        if ((c4 >> 3) == half) *(LAS f32x4*)(bp + 5 * SC_ARR + (tt * 32 + 4 * (c4 & 7)) * 4) = v4; }
                }
                __syncthreads();
            }
            {   const int ci = SEQ / SC_T; const int t = st >> 3, v4 = st & 7; const LAS float* yb = (const LAS float*)(F.lds + SC_YOFF + ((ci - 1) & 1) * SC_YB);
                *(GAS f32x4*)(Y + gbase + (size_t)((ci - 1) * SC_T + t) * D + 32 * half + 4 * v4) = *(const LAS f32x4*)(yb + t * 32 + 4 * v4); }
        } else {
            const int row = lane >> 3, kg = lane & 7, vr = 8 * wave + row;
            typedef float f32x2 __attribute__((ext_vector_type(2)));
            f32x2 s[4];
#pragma unroll
            for (int i = 0; i < 4; ++i) s[i] = (f32x2){0.f, 0.f};
            __syncthreads();
            for (int ci = 0; ci < SEQ / SC_T; ++ci) {
                const LAS unsigned char* bp = F.lds + (ci & 1) * SC_BUF; LAS float* yb = (LAS float*)(F.lds + SC_YOFF + (ci & 1) * SC_YB);
#define SC_LOAD(R_, W_, K_, A_, B_, V_, t_) do { const int lo_ = ((t_) * 64 + 8 * kg) * 4; \
                    const f32x4 ra_ = *(const LAS f32x4*)(bp + 0 * SC_ARR + lo_), rb_ = *(const LAS f32x4*)(bp + 0 * SC_ARR + lo_ + 16); \
                    const f32x4 wa_ = *(const LAS f32x4*)(bp + 1 * SC_ARR + lo_), wb_ = *(const LAS f32x4*)(bp + 1 * SC_ARR + lo_ + 16); \
                    const f32x4 ka_ = *(const LAS f32x4*)(bp + 2 * SC_ARR + lo_), kb_ = *(const LAS f32x4*)(bp + 2 * SC_ARR + lo_ + 16); \
                    const f32x4 aa_ = *(const LAS f32x4*)(bp + 3 * SC_ARR + lo_), ab_ = *(const LAS f32x4*)(bp + 3 * SC_ARR + lo_ + 16); \
                    const f32x4 ba_ = *(const LAS f32x4*)(bp + 4 * SC_ARR + lo_), bb_ = *(const LAS f32x4*)(bp + 4 * SC_ARR + lo_ + 16); \
                    V_ = *(const LAS float*)(bp + 5 * SC_ARR + ((t_) * 32 + vr) * 4); \
                    R_[0] = (f32x2){ra_[0], ra_[1]}; R_[1] = (f32x2){ra_[2], ra_[3]}; R_[2] = (f32x2){rb_[0], rb_[1]}; R_[3] = (f32x2){rb_[2], rb_[3]}; \
                    W_[0] = (f32x2){wa_[0], wa_[1]}; W_[1] = (f32x2){wa_[2], wa_[3]}; W_[2] = (f32x2){wb_[0], wb_[1]}; W_[3] = (f32x2){wb_[2], wb_[3]}; \
                    K_[0] = (f32x2){ka_[0], ka_[1]}; K_[1] = (f32x2){ka_[2], ka_[3]}; K_[2] = (f32x2){kb_[0], kb_[1]}; K_[3] = (f32x2){kb_[2], kb_[3]}; \
                    A_[0] = (f32x2){aa_[0], aa_[1]}; A_[1] = (f32x2){aa_[2], aa_[3]}; A_[2] = (f32x2){ab_[0], ab_[1]}; A_[3] = (f32x2){ab_[2], ab_[3]}; \
                    B_[0] = (f32x2){ba_[0], ba_[1]}; B_[1] = (f32x2){ba_[2], ba_[3]}; B_[2] = (f32x2){bb_[0], bb_[1]}; B_[3] = (f32x2){bb_[2], bb_[3]}; } while (0)
#define SC_STEP(R_, W_, K_, A_, B_, V_, t_) do { \
                    f32x2 q0_ = s[0] * A_[0], q1_ = s[1] * A_[1]; q0_ = s[2] * A_[2] + q0_; q1_ = s[3] * A_[3] + q1_; q0_ = q0_ + q1_; \
                    float sa_ = red8(q0_[0] + q0_[1]); \
                    const f32x2 vv_ = (f32x2){V_, V_}; \
                    f32x2 p0_ = s[0] * W_[0] + vv_ * K_[0], p1_ = s[1] * W_[1] + vv_ * K_[1], p2_ = s[2] * W_[2] + vv_ * K_[2], p3_ = s[3] * W_[3] + vv_ * K_[3]; \
                    const f32x2 sv_ = (f32x2){sa_, sa_}; \
                    s[0] = sv_ * B_[0] + p0_; s[1] = sv_ * B_[1] + p1_; s[2] = sv_ * B_[2] + p2_; s[3] = sv_ * B_[3] + p3_; \
                    f32x2 y0_ = s[0] * R_[0], y1_ = s[1] * R_[1]; y0_ = s[2] * R_[2] + y0_; y1_ = s[3] * R_[3] + y1_; y0_ = y0_ + y1_; \
                    const float y_ = red8(y0_[0] + y0_[1]); \
                    if (kg == 0) yb[(t_) * 32 + vr] = y_; } while (0)
                f32x2 r0[4], w0[4], k0[4], a0[4], b0[4], r1[4], w1[4], k1[4], a1[4], b1[4]; float v0, v1;
                SC_LOAD(r0, w0, k0, a0, b0, v0, 0);
#pragma unroll
                for (int t = 0; t < SC_T; t += 2) {
                    SC_LOAD(r1, w1, k1, a1, b1, v1, t + 1);
                    SC_STEP(r0, w0, k0, a0, b0, v0, t);
                    if (t + 2 < SC_T) SC_LOAD(r0, w0, k0, a0, b0, v0, t + 2);
                    SC_STEP(r1, w1, k1, a1, b1, v1, t + 1);
                }
#undef SC_LOAD
#undef SC_STEP
                __syncthreads();
            }
        }
    }
    __syncthreads();
}

__device__ __forceinline__ void rwkv_post_phase(Frame& F, const float* Y, const float* RKV, const float* WAG, const float* k_a, const float* r_k, const float* ln_g, const float* ln_b, bf16* MO) {
    F.ids();
    const int gw = F.vcu * NWAVES + F.wave, NGW = F.G * NWAVES, lane = F.lane;
    for (int it = gw; it < M * 32; it += NGW) {
        const int row = it >> 5, h = it & 31, c = h * 64 + lane; const size_t o = (size_t)row * D + c;
        const float y = Y[o], r = RKV[o], k = RKV[(size_t)M * D + o], v = RKV[2 * (size_t)M * D + o], a = WAG[(size_t)M * D + o], g = WAG[2 * (size_t)M * D + o];
        const float mean = wave_sum(y) * (1.0f / 64.0f), dy = y - mean, var = wave_sum(dy * dy) * (1.0f / 64.0f);
        const float yn = dy * __builtin_amdgcn_rsqf(var + 6.4e-4f) * ln_g[c] + ln_b[c];
        const float kn = k * (1.0f + (a - 1.0f) * k_a[c]);
        const float bonus = wave_sum(r * kn * r_k[c]) * v;
        MO[o] = (bf16)f2bf((yn + bonus) * g);
    }
}

__device__ __forceinline__ void final_norm_phase(Frame& F, float* X, const float* gn) {
    F.ids();
    const int gw = F.vcu * NWAVES + F.wave, NGW = F.G * NWAVES, lane = F.lane;
    for (int m = gw; m < M; m += NGW) {
        GAS f32x4* xr = (GAS f32x4*)(X + (size_t)m * D) + lane; const GAS f32x4* g4 = (const GAS f32x4*)gn + lane;
        f32x4 v[8]; float s = 0.f;
#pragma unroll
        for (int j = 0; j < 8; ++j) { v[j] = xr[64 * j]; s += (v[j][0] * v[j][0] + v[j][1] * v[j][1]) + (v[j][2] * v[j][2] + v[j][3] * v[j][3]); }
        const float rs = __builtin_amdgcn_rsqf(wave_sum(s) * (1.0f / D) + 1e-6f);
#pragma unroll
        for (int j = 0; j < 8; ++j) xr[64 * j] = v[j] * rs * g4[64 * j];
    }
}

constexpr int NPH = 43;
__host__ __device__ constexpr bool phase_used(int ph) {
    if (ph < 2 || ph == NPH - 1) return true;
    const int L = (ph - 2) / 10, s = (ph - 2) % 10, kind = L % 3;
    if (s >= 6) return true;
    return kind == 0 ? s < 4 : (kind == 1 ? true : s < 3);
}

#define IN(k) (lo <= (k) && (k) < hi)
#if MK_PER_PHASE
#define SEAM(k) do { } while (0)
#else
#define SEAM(k) do { if ((k) + 1 < hi) { XcdBarrier b_; b_.bar = (unsigned*)(ws + WS_CTL) + CW_BAR; b_.x = xb_xcc_id(); b_.st = (volatile LAS unsigned*)(F.lds + MISC_OFF) + 8; xcd_barrier(b_); } } while (0)
#endif
#define ws ((unsigned char*)in_ptr(F, T_WS))
#define XO ((float*)in_ptr(F, T_OUT))
#define INP(i) in_ptr(F, (i))
#define MO ((bf16*)(ws + WS_MO))
#define scr (ws + WS_SCR)
template <int L> __device__ __forceinline__ void layer_phases(Frame& F, const int lo, const int hi, const XcdBarrier& bar, const int bid) {
    constexpr int pb = 2 + 10 * L, kind = L % 3, j = L / 3, ver = 3 * L;
#define xcur ((L == 0) ? INP(I_X) : (const float*)XO)
#define XB0 ((bf16*)(ws + WS_XB))
#define SQ0 ((float*)(ws + WS_SSQ))
#define XBV(v) (XB0 + (size_t)((v) & 1) * M * D)
#define SQV(v) (SQ0 + (size_t)((v) & 1) * M * 32)
#define Wout ((const bf16*)(ws + (kind == 0 ? WS_WAO + (size_t)j * 8 * MiB : (kind == 1 ? WS_WRO : WS_WCOUT))))
    if constexpr (kind == 0) {
#define QKV ((bf16*)(scr + SC_QKV))
#define O12 ((bf16*)(scr + SC_O12))
#define LSE ((float*)(scr + SC_LSE))
        if (IN(pb + 0)) {
            pg8::Gemm g{XBV(ver), (const bf16*)(ws + WS_WQKV + (size_t)j * 72 * MiB), M, NQKV, D, 0, 1 << 30, 1 << 30};
            pg8::StaticOrder S; S.init(M, NQKV, F.G, bid);
            pg8::EpiScaleBf16<true> E{QKV, NQKV, SQV(ver), 0, 0};
            pg8::gemm_phase<pg8::EpiScaleBf16<true>, pg8::StaticOrder, true, true>(F.lds, g, S, E, F.wave);
            SEAM(pb + 0);
        }
        if (IN(pb + 1)) { attn_phase<false>(F, QKV, O12, LSE, MO); SEAM(pb + 1); }
        if (IN(pb + 2)) { attn_phase<true>(F, QKV, O12, LSE, MO); SEAM(pb + 2); }
    } else if constexpr (kind == 1) {
#define MIX ((bf16*)(scr + SC_MIX))
#define WAG ((float*)(scr + SC_WAG))
#define RKV ((float*)(scr + SC_RKV))
#define T1 ((bf16*)(scr + SC_T1))
#define YB ((float*)(scr + SC_Y))
        if (IN(pb + 0)) { rwkv_mix_phase(F, xcur, SQV(ver), INP(I_RWKV_NORM) + (size_t)j * D, INP(I_RWKV_MU) + (size_t)j * 6 * D, MIX); SEAM(pb + 0); }
        if (IN(pb + 1)) {
            pg8::Gemm g{MIX, (const bf16*)(ws + WS_WR1), M, 6912, D, (size_t)M * D * 2, 8, 24};
            pg8::StaticOrder S; S.init(M, 6912, F.G, bid);
            pg8::EpiR1 E{RKV, T1, M};
            pg8::gemm_phase<pg8::EpiR1, pg8::StaticOrder, true, true>(F.lds, g, S, E, F.wave);
            SEAM(pb + 1);
        }
        if (IN(pb + 2)) {
            pg8::Gemm g{T1, (const bf16*)(ws + WS_WR2), M, 3 * D, 256, (size_t)M * 256 * 2, 8, 1 << 30};
            pg8::StaticOrder S; S.init(M, 3 * D, F.G, bid);
            pg8::EpiR2 E{WAG, INP(I_RWKV_W0) + (size_t)j * D, INP(I_RWKV_A0) + (size_t)j * D, M};
            pg8::gemm_phase<pg8::EpiR2, pg8::StaticOrder, true, true>(F.lds, g, S, E, F.wave);
            SEAM(pb + 2);
        }
        if (IN(pb + 3)) { rwkv_scan_phase(F, RKV, WAG, INP(I_RWKV_KK) + (size_t)j * D, INP(I_RWKV_KA) + (size_t)j * D, YB); SEAM(pb + 3); }
        if (IN(pb + 4)) { rwkv_post_phase(F, YB, RKV, WAG, INP(I_RWKV_KA) + (size_t)j * D, INP(I_RWKV_RK) + (size_t)j * D, INP(I_RWKV_LNG) + (size_t)j * D, INP(I_RWKV_LNB) + (size_t)j * D, MO); SEAM(pb + 4); }
    } else {
#define BCU ((bf16*)(scr + SC_BCU))
        if (IN(pb + 0)) {
            pg8::Gemm g{XBV(ver), (const bf16*)(ws + WS_WCIN), M, 3 * D, D, 0, 1 << 30, 1 << 30};
            pg8::StaticOrder S; S.init(M, 3 * D, F.G, bid);
            pg8::EpiScaleBf16<true> E{BCU, 3 * D, SQV(ver), 0, 0};
            pg8::gemm_phase<pg8::EpiScaleBf16<true>, pg8::StaticOrder, true, true>(F.lds, g, S, E, F.wave);
            SEAM(pb + 0);
        }
        if (IN(pb + 1)) { conv_mix_phase(F, BCU, MO, INP(I_CONV_W) + (size_t)j * 3 * D); SEAM(pb + 1); }
    }
    constexpr int ps_out = pb + (kind == 0 ? 3 : (kind == 1 ? 5 : 2));
    if (IN(ps_out)) {
        pg8::Gemm g{MO, Wout, M, D, D, 0, 1 << 30, 1 << 30};
        pg8::StaticOrder S; S.init(M, D, F.G, bid);
        pg8::EpiResid E{xcur, XO, XBV(ver + 1), SQV(ver + 1)};
        pg8::gemm_phase<pg8::EpiResid, pg8::StaticOrder, true, true>(F.lds, g, S, E, F.wave);
        SEAM(ps_out);
    }
#define GU ((bf16*)(scr + SC_GU))
#define ACT ((bf16*)(scr + SC_ACT))
    if (IN(pb + 6)) {
        pg8::Gemm g{XBV(ver + 1), (const bf16*)(ws + WS_WGU + (size_t)L * 44 * MiB), M, 2 * FF, D, 0, 1 << 30, 1 << 30};
        pg8::StaticOrder S; S.init(M, 2 * FF, F.G, bid);
        pg8::EpiScaleBf16<true> E{GU, 2 * FF, SQV(ver + 1), 0, 0};
        pg8::gemm_phase<pg8::EpiScaleBf16<true>, pg8::StaticOrder, true, true>(F.lds, g, S, E, F.wave);
        SEAM(pb + 6);
    }
    if (IN(pb + 7)) { ffn_act_phase(F, GU, ACT, INP(I_FFN_CONVW) + (size_t)L * 3 * FF, INP(I_FFN_CONVB) + (size_t)L * FF); SEAM(pb + 7); }
    if (IN(pb + 8)) {
        pg8::Gemm g{ACT, (const bf16*)(ws + WS_WDN + (size_t)L * 22 * MiB), M, D, FF, 0, 1 << 30, 1 << 30};
        pg8::StaticOrder S; S.init(M, D, F.G, bid);
        pg8::EpiResid E{XO, XO, XBV(ver + 2), SQV(ver + 2)};
        pg8::gemm_phase<pg8::EpiResid, pg8::StaticOrder, true, true>(F.lds, g, S, E, F.wave);
        SEAM(pb + 8);
    }
    if (IN(pb + 9)) {
        pg8::Gemm g{XBV(ver + 2), (const bf16*)(ws + WS_WPG + (size_t)L * 8 * MiB), M, D, D, 0, 1 << 30, 1 << 30};
        pg8::StaticOrder S; S.init(M, D, F.G, bid);
        pg8::EpiPle E{SQV(ver + 2), XO, (const bf16*)(ws + WS_PPO) + (size_t)L * M * D, XO, XBV(ver + 3), SQV(ver + 3)};
        pg8::gemm_phase<pg8::EpiPle, pg8::StaticOrder, true, true>(F.lds, g, S, E, F.wave);
        SEAM(pb + 9);
    }
}

__global__ void __launch_bounds__(NTHR, 2) mega_fwd(Params P) {
    extern __shared__ __attribute__((aligned(16))) unsigned char lds_raw[];
    Frame F;
    F.lds = (LAS unsigned char*)lds_raw;
    F.wave = __builtin_amdgcn_readfirstlane((int)threadIdx.x >> 6); F.ids();
    F.G = gridDim.x; { const int bx = blockIdx.x; F.vcu = (F.G % 8 == 0) ? (bx % 8) * (F.G / 8) + bx / 8 : bx; }
    volatile LAS unsigned* MISC = (volatile LAS unsigned*)(F.lds + MISC_OFF);
    for (int u = F.tid; u < (LDS_BYTES - RING_BYTES) / 4; u += NTHR) ((LAS unsigned*)(F.lds + RING_BYTES))[u] = 0u;
    __syncthreads();
    if (F.tid == 0) {
#pragma unroll
        for (int i = 0; i < 35; ++i) ((LAS unsigned long long*)(F.lds + PTR_OFF))[i] = (unsigned long long)(size_t)P.in[i];
        ((LAS unsigned long long*)(F.lds + PTR_OFF))[T_OUT] = (unsigned long long)(size_t)P.out; ((LAS unsigned long long*)(F.lds + PTR_OFF))[T_WS] = (unsigned long long)(size_t)P.wsp; }
    __syncthreads();
    XcdBarrier bar; bar.bar = nullptr; bar.x = 0; bar.st = nullptr;
#if !MK_PER_PHASE
    (void)xcd_barrier_post((unsigned*)(P.wsp + WS_CTL) + CW_BAR, MISC + 8);
#endif
    const int lo = P.lo, hi = P.hi;
    const int bid = (int)blockIdx.x;

    if (IN(0)) { p_prologue(F); SEAM(0); }
    if (IN(1)) {
        pg8::Gemm g{(const bf16*)(ws + WS_PB), (const bf16*)(ws + WS_WPP), M, 4 * D, PLE, (size_t)M * PLE * 2, 8, 1 << 30};
        pg8::StaticOrder S; S.init(M, 4 * D, F.G, bid);
        pg8::EpiScaleBf16<false> E{(bf16*)(ws + WS_PPO), D, nullptr, D, (size_t)M * D};
        pg8::gemm_phase<pg8::EpiScaleBf16<false>, pg8::StaticOrder, true, true>(F.lds, g, S, E, F.wave);
        SEAM(1);
    }
    layer_phases<0>(F, lo, hi, bar, bid);
    layer_phases<1>(F, lo, hi, bar, bid);
    layer_phases<2>(F, lo, hi, bar, bid);
    layer_phases<3>(F, lo, hi, bar, bid);
    if (IN(NPH - 1)) final_norm_phase(F, XO, INP(I_FINAL_NORM));
#undef IN
#undef SEAM
#undef ws
#undef XO
#undef INP
#undef MO
#undef scr
#undef xcur
#undef XB0
#undef SQ0
#undef Wout
#undef QKV
#undef O12
#undef LSE
#undef MIX
#undef WAG
#undef RKV
#undef T1
#undef YB
#undef BCU
#undef GU
#undef ACT
#undef XBV
#undef SQV
}

extern "C" void kernel_launch(void* const* d_in, const int* in_sizes, int n_in, void* d_out, int out_size, void* d_ws, size_t ws_size, hipStream_t stream) {
    static int grid = 0;
    if (grid == 0) {
        if (n_in != 35 || out_size != M * D || ws_size < WS_END) { fprintf(stderr, "kernel_launch: unexpected problem: n_in %d out %d ws %zu (need %zu)\n", n_in, out_size, ws_size, (size_t)WS_END); grid = -1; return; }
        int dev = 0, cus = 0, per_cu = 0;
        if (hipGetDevice(&dev) != hipSuccess || hipDeviceGetAttribute(&cus, hipDeviceAttributeMultiprocessorCount, dev) != hipSuccess) { grid = -1; return; }
        if (hipFuncSetAttribute((const void*)mega_fwd, hipFuncAttributeMaxDynamicSharedMemorySize, LDS_BYTES) != hipSuccess) { fprintf(stderr, "kernel_launch: hipFuncSetAttribute failed\n"); grid = -1; return; }
        if (hipOccupancyMaxActiveBlocksPerMultiprocessor(&per_cu, (const void*)mega_fwd, NTHR, LDS_BYTES) != hipSuccess || per_cu < 1) fprintf(stderr, "kernel_launch: occupancy query says %d blocks per CU\n", per_cu);
        (void)hipGetLastError();
        grid = cus;
    }
    if (grid < 0) return;
    if (hipMemsetAsync((char*)d_ws + WS_CTL, 0, CTL_ZERO_BYTES, stream) != hipSuccess) return;
    Params a{};
    for (int i = 0; i < 35; ++i) a.in[i] = (const float*)d_in[i];
    a.out = (float*)d_out; a.wsp = (unsigned char*)d_ws;
#if MK_PER_PHASE
    for (int ph = 0; ph < NPH; ++ph) { if (!phase_used(ph)) continue; a.lo = ph; a.hi = ph + 1;
        for (int rep = 0; rep < ((ph == PROBE_PH || ph == PROBE_PH2) ? 1 + PROBE_REPS : 1); ++rep) hipLaunchKernelGGL(mega_fwd, dim3(grid), dim3(NTHR), LDS_BYTES, stream, a); }
#else
    a.lo = 0; a.hi = NPH; hipLaunchKernelGGL(mega_fwd, dim3(grid), dim3(NTHR), LDS_BYTES, stream, a);
#endif
}
```

```cpp
#include <hip/hip_runtime.h>
#include <cstdio>
#include <cstdint>
__device__ __forceinline__ int fresh_lane() { int l; asm volatile("v_mbcnt_lo_u32_b32 %0, -1, 0\n\tv_mbcnt_hi_u32_b32 %0, -1, %0" : "=v"(l)); return l; }
#ifndef PROBE_PH
#define PROBE_PH -1
#define PROBE_PH2 -1
#define PROBE_REPS 0
#endif
#ifndef MK_PER_PHASE
#define MK_PER_PHASE 0
#endif
namespace pg8 {
#define PG8_LAS __attribute__((address_space(3)))
typedef unsigned short bf16_t;
typedef short bf16x8 __attribute__((ext_vector_type(8)));
typedef float f32x4 __attribute__((ext_vector_type(4)));
typedef unsigned u32x4 __attribute__((ext_vector_type(4)));
constexpr int BM = 256, BK = 64, HALF = 128, HTB = HALF * BK * 2  , STAGE_BYTES = 8 * HTB, NXCD = 8, WGM = 8;

__host__ __device__ __forceinline__ int lds_byte(int r, int c) { const int st = (r >> 4) * 2 + (c >> 5), rr = r & 15, cc = c & 31, ob = rr * 64 + cc * 2; return st * 1024 + (ob ^ (((ob >> 9) & 1) << 5)); }
__host__ __device__ __forceinline__ void stage_rc(int b, int& R, int& C) { const int st = b / 1024, sb = b % 1024, swz = sb ^ (((sb >> 9) & 1) << 5); R = (st >> 1) * 16 + swz / 64; C = (st & 1) * 32 + (swz % 64) / 2; }
__host__ __device__ __forceinline__ int perm32(int rho) { const int n = rho >> 4, i = rho & 15; return 8 * (i >> 2) + 4 * n + (i & 3); }

struct Unit { int pm, pn; };
struct Gemm { const bf16_t* A; const bf16_t* Bt; int M, N, K; size_t a_stride; int grp, nsplit;
    __device__ __forceinline__ int asel(int pn) const { return pn < nsplit ? pn / grp : pn - nsplit + nsplit / grp; } };

struct StaticOrder {
    int nM, nN, nwg, G, c;
    __host__ __device__ __forceinline__ void init(int M, int N, int G_, int c_) { nM = M / BM; nN = N / BM; nwg = nM * nN; G = G_; c = c_; }
    __host__ __device__ __forceinline__ bool next(int i, Unit& u) const {
        const long L = (long)i * G + c; if (L >= nwg) return false;
        int wgid = (int)L; { const int q = nwg / NXCD, r = nwg % NXCD, xcd = wgid % NXCD, off = wgid / NXCD; wgid = (xcd < r ? xcd * (q + 1) : r * (q + 1) + (xcd - r) * q) + off; }
        const int nig = WGM * nN, gid = wgid / nig, fm = gid * WGM, gsz = (nM - fm) < WGM ? (nM - fm) : WGM;
        u.pm = fm + ((wgid % nig) % gsz); u.pn = (wgid % nig) / gsz; return true;
    }
    __device__ __forceinline__ void a_ready(const Unit&) const {}
    __device__ __forceinline__ void done(const Unit&) const {}
};

__device__ __forceinline__ unsigned cvt_pk_bf16(float lo, float hi) { unsigned r; asm volatile("v_cvt_pk_bf16_f32 %0, %1, %2" : "=v"(r) : "v"(lo), "v"(hi)); return r; }
typedef float f32x2 __attribute__((ext_vector_type(2)));
typedef unsigned u32x2 __attribute__((ext_vector_type(2)));
constexpr int DM = 2048;
constexpr int NPART = 32;
__device__ __forceinline__ float bf2f(unsigned short b) { return __uint_as_float(((unsigned)b) << 16); }
__device__ __forceinline__ float fast_sigmoid(float z) { return __builtin_amdgcn_rcpf(1.0f + __expf(-z)); }

__device__ __forceinline__ void rows_rstd(const float* ssq, int row0, int fq, float (&rs)[2][4]) {
#pragma unroll
    for (int ai = 0; ai < 2; ++ai)
#pragma unroll
        for (int m = 0; m < 4; ++m) { const f32x4* p = (const f32x4*)(ssq + (size_t)(row0 + ai * HALF + m * 16) * NPART + fq * 8); const f32x4 a = p[0], b = p[1];
            float s = ((a[0] + a[1]) + (a[2] + a[3])) + ((b[0] + b[1]) + (b[2] + b[3])); s += __shfl_xor(s, 16); s += __shfl_xor(s, 32);
            rs[ai][m] = __builtin_amdgcn_rsqf(s * (1.0f / (float)DM) + 1e-6f); }
}

template <bool SCALE> struct EpiScaleBf16 {
    static constexpr bool PERM = true, AFTER_DRAIN = false;
    bf16_t* O; int ldc; const float* ssq; int split_cols; size_t split_stride;
    __device__ __forceinline__ void operator()(const f32x4 (&acc)[2][2][4][2], const Unit& u, int wr, int wc, int fr, int fq) const {
        const int row0 = u.pm * BM + wr * 64 + fr; int colt = u.pn * BM; bf16_t* base = O;
        if (split_cols) { const int t = colt / split_cols; base += (size_t)t * split_stride; colt -= t * split_cols; }
        const int col0 = colt + wc * 32 + 8 * fq;
        float rs[2][4];
        if (SCALE) rows_rstd(ssq, row0, fq, rs);
#pragma unroll
        for (int ai = 0; ai < 2; ++ai)
#pragma unroll
            for (int m = 0; m < 4; ++m) { bf16_t* rowp = base + (size_t)(row0 + ai * HALF + m * 16) * ldc + col0; const float sc = SCALE ? rs[ai][m] : 1.0f;
#pragma unroll
                for (int bj = 0; bj < 2; ++bj) { const f32x4 v0 = acc[ai][bj][m][0] * sc, v1 = acc[ai][bj][m][1] * sc;
                    u32x4 w; w.x = cvt_pk_bf16(v0[0], v0[1]); w.y = cvt_pk_bf16(v0[2], v0[3]); w.z = cvt_pk_bf16(v1[0], v1[1]); w.w = cvt_pk_bf16(v1[2], v1[3]);
                    *(u32x4*)(rowp + bj * HALF) = w; } }
    }
};

#define EPI_STORE_X(v, o) do { *(f32x4*)(X + (o)) = (v); u32x2 w_; w_.x = cvt_pk_bf16((v)[0], (v)[1]); w_.y = cvt_pk_bf16((v)[2], (v)[3]); *(u32x2*)(XB + (o)) = w_; \
        ss += ((v)[0] * (v)[0] + (v)[1] * (v)[1]) + ((v)[2] * (v)[2] + (v)[3] * (v)[3]); } while (0)

struct EpiResid {
    static constexpr bool PERM = false, AFTER_DRAIN = false;
    const float* base; float* X; bf16_t* XB; float* SSQ;
    __device__ __forceinline__ void operator()(const f32x4 (&acc)[2][2][4][2], const Unit& u, int wr, int wc, int fr, int fq) const {
        const int row0 = u.pm * BM + wr * 64 + fr, col0 = u.pn * BM + wc * 32 + 4 * fq;
#pragma unroll
        for (int ai = 0; ai < 2; ++ai)
#pragma unroll
            for (int m = 0; m < 4; ++m) { const int r = row0 + ai * HALF + m * 16; const size_t off = (size_t)r * DM + col0; float ss = 0.f;
#pragma unroll
                for (int bj = 0; bj < 2; ++bj)
#pragma unroll
                    for (int n = 0; n < 2; ++n) { const size_t o = off + bj * HALF + n * 16; const f32x4 v = *(const f32x4*)(base + o) + acc[ai][bj][m][n]; EPI_STORE_X(v, o); }
                ss += __shfl_xor(ss, 16); ss += __shfl_xor(ss, 32);
                if (fq == 0) SSQ[(size_t)r * NPART + u.pn * 4 + wc] = ss;
                if (m & 1) asm volatile("" ::: "memory"); }
    }
};

struct EpiPle {
    static constexpr bool PERM = false, AFTER_DRAIN = false;
    const float* ssq; const float* base; const bf16_t* PP; float* X; bf16_t* XB; float* SSQ;
    __device__ __forceinline__ void operator()(const f32x4 (&acc)[2][2][4][2], const Unit& u, int wr, int wc, int fr, int fq) const {
        const int row0 = u.pm * BM + wr * 64 + fr, col0 = u.pn * BM + wc * 32 + 4 * fq;
        float rs[2][4]; rows_rstd(ssq, row0, fq, rs);
#pragma unroll
        for (int ai = 0; ai < 2; ++ai)
#pragma unroll
            for (int m = 0; m < 4; ++m) { const int r = row0 + ai * HALF + m * 16; const size_t off = (size_t)r * DM + col0; float ss = 0.f; const float sc = rs[ai][m];
#pragma unroll
                for (int bj = 0; bj < 2; ++bj)
#pragma unroll
                    for (int n = 0; n < 2; ++n) { const size_t o = off + bj * HALF + n * 16; const f32x4 xv = *(const f32x4*)(base + o); const u32x2 pw = *(const u32x2*)(PP + o); const f32x4 a = acc[ai][bj][m][n];
                        f32x4 v; v[0] = xv[0] + fast_sigmoid(a[0] * sc) * __uint_as_float(pw.x << 16); v[1] = xv[1] + fast_sigmoid(a[1] * sc) * __uint_as_float(pw.x & 0xffff0000u);
                        v[2] = xv[2] + fast_sigmoid(a[2] * sc) * __uint_as_float(pw.y << 16); v[3] = xv[3] + fast_sigmoid(a[3] * sc) * __uint_as_float(pw.y & 0xffff0000u);
                        EPI_STORE_X(v, o); }
                ss += __shfl_xor(ss, 16); ss += __shfl_xor(ss, 32);
                if (fq == 0) SSQ[(size_t)r * NPART + u.pn * 4 + wc] = ss;
                if (m & 1) asm volatile("" ::: "memory"); }
    }
};

struct EpiR1 {
    static constexpr bool PERM = false, AFTER_DRAIN = false;
    float* RKV; bf16_t* T1; int M;
    __device__ __forceinline__ void operator()(const f32x4 (&acc)[2][2][4][2], const Unit& u, int wr, int wc, int fr, int fq) const {
        const int row0 = u.pm * BM + wr * 64 + fr, cl0 = wc * 32 + 4 * fq;
        if (u.pn < 24) {
            float* O = RKV + (size_t)(u.pn >> 3) * M * DM + (u.pn & 7) * BM + cl0;
#pragma unroll
            for (int ai = 0; ai < 2; ++ai)
#pragma unroll
                for (int m = 0; m < 4; ++m) { float* rowp = O + (size_t)(row0 + ai * HALF + m * 16) * DM;
#pragma unroll
                    for (int bj = 0; bj < 2; ++bj)
#pragma unroll
                        for (int n = 0; n < 2; ++n) *(f32x4*)(rowp + bj * HALF + n * 16) = acc[ai][bj][m][n]; }
        } else {
            const int mode = u.pn - 24; bf16_t* O = T1 + (size_t)mode * M * 256 + cl0;
#pragma unroll
            for (int ai = 0; ai < 2; ++ai)
#pragma unroll
                for (int m = 0; m < 4; ++m) { bf16_t* rowp = O + (size_t)(row0 + ai * HALF + m * 16) * 256;
#pragma unroll
                    for (int bj = 0; bj < 2; ++bj)
#pragma unroll
                        for (int n = 0; n < 2; ++n) { f32x4 v = acc[ai][bj][m][n];
                            if (mode == 0) {
#pragma unroll
                                for (int j = 0; j < 4; ++j) v[j] = 1.0f - 2.0f * __builtin_amdgcn_rcpf(1.0f + __expf(2.0f * v[j])); }
                            else if (mode == 2) {
#pragma unroll
                                for (int j = 0; j < 4; ++j) v[j] = fast_sigmoid(v[j]); }
                            u32x2 w; w.x = cvt_pk_bf16(v[0], v[1]); w.y = cvt_pk_bf16(v[2], v[3]); *(u32x2*)(rowp + bj * HALF + n * 16) = w; } }
        }
    }
};

struct EpiR2 {
    static constexpr bool PERM = false, AFTER_DRAIN = false;
    float* WAG; const float* w0; const float* a0; int M;
    __device__ __forceinline__ void operator()(const f32x4 (&acc)[2][2][4][2], const Unit& u, int wr, int wc, int fr, int fq) const {
        const int row0 = u.pm * BM + wr * 64 + fr, which = u.pn >> 3, col0 = (u.pn & 7) * BM + wc * 32 + 4 * fq;
        float* O = WAG + (size_t)which * M * DM + col0;
        f32x4 bv[2][2];
#pragma unroll
        for (int bj = 0; bj < 2; ++bj)
#pragma unroll
            for (int n = 0; n < 2; ++n) bv[bj][n] = which == 0 ? *(const f32x4*)(w0 + col0 + bj * HALF + n * 16) : (which == 1 ? *(const f32x4*)(a0 + col0 + bj * HALF + n * 16) : (f32x4){0.f, 0.f, 0.f, 0.f});
#pragma unroll
        for (int ai = 0; ai < 2; ++ai)
#pragma unroll
            for (int m = 0; m < 4; ++m) { float* rowp = O + (size_t)(row0 + ai * HALF + m * 16) * DM;
#pragma unroll
                for (int bj = 0; bj < 2; ++bj)
#pragma unroll
                    for (int n = 0; n < 2; ++n) { f32x4 v = acc[ai][bj][m][n] + bv[bj][n];
                        if (which == 0) {
#pragma unroll
                            for (int j = 0; j < 4; ++j) v[j] = __expf(-0.6065306597126334f * fast_sigmoid(v[j])); }
                        else if (which == 1) {
#pragma unroll
                            for (int j = 0; j < 4; ++j) v[j] = fast_sigmoid(v[j]); }
                        *(f32x4*)(rowp + bj * HALF + n * 16) = v; } }
    }
};

template <int CTRL> __device__ __forceinline__ float dppf(float x) { return __int_as_float(__builtin_amdgcn_update_dpp(0, __float_as_int(x), CTRL, 0xF, 0xF, true)); }
constexpr int FFN_F = 5632, FFN_NT = 44;
struct EpiFfnAct {
    static constexpr bool PERM = true, AFTER_DRAIN = false;
    bf16_t* ACT; const float* ssq; const float* cw; const float* cb; float* GH; float* OWN; PG8_LAS float* H;
    __device__ __forceinline__ void operator()(f32x4 (&acc)[2][2][4][2], const Unit& u, int wr, int wc, int fr, int fq) const {
        const int row0 = u.pm * BM + wr * 64 + fr, chl = wc * 32 + 8 * fq, ch0 = u.pn * 128 + chl;
        { float rs[2][4]; rows_rstd(ssq, row0, fq, rs);
#pragma unroll
          for (int ai = 0; ai < 2; ++ai)
#pragma unroll
              for (int m = 0; m < 4; ++m)
#pragma unroll
                  for (int n = 0; n < 2; ++n) { acc[ai][0][m][n] *= rs[ai][m]; acc[ai][1][m][n] *= rs[ai][m]; } }
        if (fr >= 14) {
#pragma unroll
            for (int ai = 0; ai < 2; ++ai)
#pragma unroll
                for (int n = 0; n < 2; ++n) *(PG8_LAS f32x4*)(H + ((2 * ai + wr) * 2 + (fr - 14)) * 128 + chl + 4 * n) = acc[ai][0][3][n];
            if (wr == 1) {
#pragma unroll
                for (int n = 0; n < 2; ++n) *(f32x4*)(GH + (((size_t)u.pm * FFN_NT + u.pn) * 2 + (fr - 14)) * 128 + chl + 4 * n) = acc[1][0][3][n]; }
        }
        asm volatile("s_waitcnt lgkmcnt(0)" ::: "memory"); __builtin_amdgcn_s_barrier(); asm volatile("" ::: "memory");
        f32x4 w0[2], w1[2], w2[2], bb[2];
#pragma unroll
        for (int n = 0; n < 2; ++n) { w0[n] = *(const f32x4*)(cw + ch0 + 4 * n); w1[n] = *(const f32x4*)(cw + FFN_F + ch0 + 4 * n); w2[n] = *(const f32x4*)(cw + 2 * FFN_F + ch0 + 4 * n); bb[n] = *(const f32x4*)(cb + ch0 + 4 * n); }
        const bool defer = (u.pm & 7) != 0;
#pragma unroll
        for (int ai = 0; ai < 2; ++ai) {
            const int seg = 2 * ai + wr;
            f32x4 p1[2], p2[2];
#pragma unroll
            for (int n = 0; n < 2; ++n) { f32x4 g = (f32x4){0.f, 0.f, 0.f, 0.f};
                if (seg > 0 && fr >= 14) g = *(const PG8_LAS f32x4*)(H + ((seg - 1) * 2 + (fr - 14)) * 128 + chl + 4 * n);
#pragma unroll
                for (int jj = 0; jj < 4; ++jj) { p1[n][jj] = dppf<0x121>(g[jj]); p2[n][jj] = dppf<0x122>(g[jj]); } }
#pragma unroll
            for (int m = 0; m < 4; ++m) {
                float o[8];
#pragma unroll
                for (int n = 0; n < 2; ++n)
#pragma unroll
                    for (int jj = 0; jj < 4; ++jj) { const float cur = acc[ai][0][m][n][jj], c1 = dppf<0x121>(cur), c2 = dppf<0x122>(cur);
                        const float r1 = fr == 0 ? p1[n][jj] : c1, r2 = fr < 2 ? p2[n][jj] : c2;
                        p1[n][jj] = c1; p2[n][jj] = c2;
                        const float z = w0[n][jj] * r2 + w1[n][jj] * r1 + w2[n][jj] * cur + bb[n][jj];
                        o[4 * n + jj] = z * fast_sigmoid(z) * acc[ai][1][m][n][jj]; }
                const int r = row0 + ai * HALF + m * 16;
                if (defer && seg == 0 && m == 0 && fr < 2) {
                    float* ow = OWN + (((size_t)u.pm * FFN_NT + u.pn) * 2 + fr) * 256 + chl;
#pragma unroll
                    for (int n = 0; n < 2; ++n) { *(f32x4*)(ow + 4 * n) = acc[0][0][0][n]; *(f32x4*)(ow + 128 + 4 * n) = acc[0][1][0][n]; }
                } else {
                    u32x4 w; w.x = cvt_pk_bf16(o[0], o[1]); w.y = cvt_pk_bf16(o[2], o[3]); w.z = cvt_pk_bf16(o[4], o[5]); w.w = cvt_pk_bf16(o[6], o[7]);
                    *(u32x4*)(ACT + (size_t)r * FFN_F + ch0) = w; }
            }
        }
    }
};
template <class Epi, class Sched, bool ALIGN_EPI = false, bool SP2 = false>
__device__ __forceinline__ void gemm_phase(PG8_LAS unsigned char* lds, const Gemm g, const Sched& S, const Epi& E, const int wid  ) {
    const int lane = fresh_lane(), tid = wid * 64 + lane, wr = wid >> 2, wc = wid & 3, fr = lane & 15, fq = lane >> 4;
    const int K = g.K, nt = K / BK;
    unsigned voffA[2], voffB[2];
#pragma unroll
    for (int i = 0; i < 2; ++i) { int R, C; stage_rc(tid * 16 + i * 8192, R, C); const int Rb = Epi::PERM ? ((R & ~31) + perm32(R & 31)) : R;
        voffA[i] = (unsigned)(R * K + C) * 2u; voffB[i] = (unsigned)(Rb * K + C) * 2u; }
    const size_t kstep = (size_t)(BK * 2);
    const size_t hstep = (size_t)HALF * K * 2;
    const size_t tstep = 2 * hstep;
    const unsigned ldsw = (unsigned)wid * 1024u;
    const int aoff = lds_byte(wr * 64 + fr, fq * 8), boff = lds_byte(wc * 32 + fr, fq * 8);
#define PG8_SA(b, h) (((b) * 2 + (h)) * HTB)
#define PG8_SB(b, h) ((4 + (b) * 2 + (h)) * HTB)
#define PG8_STAGE(bufoff, gbase, voff) do { _Pragma("unroll") for (int _i = 0; _i < 2; ++_i) \
        __builtin_amdgcn_global_load_lds((const unsigned*)((const char*)(gbase) + (voff)[_i]), (PG8_LAS unsigned*)(lds + (bufoff) + ldsw + _i * 8192), 16, 0, 0); } while (0)
#define PG8_LDA(dst, b, h) do { _Pragma("unroll") for (int m = 0; m < 4; ++m) _Pragma("unroll") for (int k = 0; k < 2; ++k) dst[m][k] = *(const PG8_LAS bf16x8*)(lds + PG8_SA(b, h) + aoff + m * 2048 + k * 1024); } while (0)
#define PG8_LDB(dst, b, h) do { _Pragma("unroll") for (int n = 0; n < 2; ++n) _Pragma("unroll") for (int k = 0; k < 2; ++k) dst[n][k] = *(const PG8_LAS bf16x8*)(lds + PG8_SB(b, h) + boff + n * 2048 + k * 1024); } while (0)
#define PG8_MMA(ai, bj, At, Bt) do { __builtin_amdgcn_s_setprio(1); _Pragma("unroll") for (int m = 0; m < 4; ++m) _Pragma("unroll") for (int n = 0; n < 2; ++n) _Pragma("unroll") for (int k = 0; k < 2; ++k) \
        acc[ai][bj][m][n] = __builtin_amdgcn_mfma_f32_16x16x32_bf16(Bt[n][k], At[m][k], acc[ai][bj][m][n], 0, 0, 0); __builtin_amdgcn_s_setprio(0); } while (0)
#define PG8_WAIT_V(n) asm volatile("s_waitcnt vmcnt(" #n ")" ::: "memory")
#define PG8_WAIT_L(n) asm volatile("s_waitcnt lgkmcnt(" #n ")" ::: "memory")
#define PG8_BAR __builtin_amdgcn_s_barrier()
#define PG8_SCHED __builtin_amdgcn_sched_barrier(0)
    Unit cur, nxt; int ui = 0;
    if (!S.next(0, cur)) return;
    f32x4 acc[2][2][4][2];
#pragma unroll
    for (int a = 0; a < 2; ++a)
#pragma unroll
        for (int b = 0; b < 2; ++b)
#pragma unroll
            for (int m = 0; m < 4; ++m)
#pragma unroll
                for (int n = 0; n < 2; ++n) acc[a][b][m][n] = (f32x4){0.f, 0.f, 0.f, 0.f};
    bf16x8 At[4][2], B0[2][2], B1[2][2];
    const char* cA = (const char*)g.A + (size_t)g.asel(cur.pn) * g.a_stride + (size_t)cur.pm * tstep; const char* cB = (const char*)g.Bt + (size_t)cur.pn * tstep;
    S.a_ready(cur);
    if constexpr (SP2) {
        PG8_STAGE(PG8_SB(0, 0), cB, voffB); PG8_STAGE(PG8_SB(0, 1), cB + hstep, voffB); PG8_STAGE(PG8_SA(0, 0), cA, voffA); PG8_STAGE(PG8_SA(0, 1), cA + hstep, voffA);
        if (wr == 1) PG8_BAR;
        PG8_WAIT_V(2); PG8_BAR;
        PG8_STAGE(PG8_SB(1, 0), cB + kstep, voffB); PG8_STAGE(PG8_SA(1, 0), cA + kstep, voffA); PG8_STAGE(PG8_SB(1, 1), cB + hstep + kstep, voffB);
        PG8_WAIT_V(6); PG8_BAR;
    } else {
        PG8_STAGE(PG8_SB(0, 0), cB, voffB); PG8_STAGE(PG8_SA(0, 0), cA, voffA); PG8_STAGE(PG8_SB(0, 1), cB + hstep, voffB); PG8_STAGE(PG8_SA(0, 1), cA + hstep, voffA);
        if (wr == 1) PG8_BAR;
        PG8_WAIT_V(4); PG8_BAR;
        PG8_STAGE(PG8_SB(1, 0), cB + kstep, voffB); PG8_STAGE(PG8_SA(1, 0), cA + kstep, voffA); PG8_STAGE(PG8_SB(1, 1), cB + hstep + kstep, voffB);
        PG8_WAIT_V(6); PG8_BAR;
    }
    for (;;) {
        const bool has_next = S.next(ui + 1, nxt);
        const char* nA = has_next ? (const char*)g.A + (size_t)g.asel(nxt.pn) * g.a_stride + (size_t)nxt.pm * tstep : cA; const char* nB = has_next ? (const char*)g.Bt + (size_t)nxt.pn * tstep : cB;
        for (int t = 0; t < nt; t += 2) {
            const bool last = (t == nt - 2);
            const char* a1 = cA + (size_t)(t + 1) * kstep;
            const char* a2 = last ? nA : cA + (size_t)(t + 2) * kstep; const char* b2 = last ? nB : cB + (size_t)(t + 2) * kstep;
            const char* a3 = a2 + kstep; const char* b3 = b2 + kstep;
            if (last && has_next) S.a_ready(nxt);
            if constexpr (SP2) {
            PG8_LDB(B0, 0, 0); PG8_LDB(B1, 0, 1); PG8_SCHED; PG8_LDA(At, 0, 0); PG8_STAGE(PG8_SA(1, 1), a1 + hstep, voffA);
            PG8_WAIT_V(8); PG8_WAIT_L(0); PG8_BAR; PG8_MMA(0, 0, At, B0); PG8_MMA(0, 1, At, B1); PG8_BAR; PG8_SCHED;
            PG8_LDA(At, 0, 1); PG8_STAGE(PG8_SB(0, 0), b2, voffB); PG8_STAGE(PG8_SB(0, 1), b2 + hstep, voffB); PG8_STAGE(PG8_SA(0, 0), a2, voffA);
            PG8_WAIT_V(8); PG8_WAIT_L(0); PG8_BAR; PG8_MMA(1, 0, At, B0); PG8_MMA(1, 1, At, B1); PG8_BAR; PG8_SCHED;
            PG8_LDB(B0, 1, 0); PG8_LDB(B1, 1, 1); PG8_SCHED; PG8_LDA(At, 1, 0); PG8_STAGE(PG8_SA(0, 1), a2 + hstep, voffA);
            PG8_WAIT_V(8); PG8_WAIT_L(0); PG8_BAR; PG8_MMA(0, 0, At, B0); PG8_MMA(0, 1, At, B1); PG8_BAR; PG8_SCHED;
            PG8_LDA(At, 1, 1); PG8_STAGE(PG8_SB(1, 0), b3, voffB); PG8_STAGE(PG8_SB(1, 1), b3 + hstep, voffB); PG8_STAGE(PG8_SA(1, 0), a3, voffA);
            PG8_WAIT_V(8); PG8_WAIT_L(0); PG8_BAR; PG8_MMA(1, 0, At, B0); PG8_MMA(1, 1, At, B1); PG8_BAR; PG8_SCHED;
            } else {
            PG8_LDB(B0, 0, 0); PG8_SCHED; PG8_LDA(At, 0, 0); PG8_STAGE(PG8_SA(1, 1), a1 + hstep, voffA);
            PG8_WAIT_L(8); PG8_BAR; PG8_WAIT_L(0); PG8_MMA(0, 0, At, B0); PG8_BAR; PG8_SCHED;
            PG8_LDB(B1, 0, 1); PG8_STAGE(PG8_SB(0, 0), b2, voffB);
            PG8_BAR; PG8_WAIT_L(0); PG8_MMA(0, 1, At, B1); PG8_BAR;
            PG8_LDA(At, 0, 1); PG8_STAGE(PG8_SA(0, 0), a2, voffA);
            PG8_BAR; PG8_WAIT_L(0); PG8_MMA(1, 0, At, B0); PG8_BAR; PG8_SCHED;
            PG8_STAGE(PG8_SB(0, 1), b2 + hstep, voffB);
            PG8_WAIT_V(6); PG8_BAR; PG8_MMA(1, 1, At, B1); PG8_BAR;
            PG8_LDB(B0, 1, 0); PG8_SCHED; PG8_LDA(At, 1, 0); PG8_STAGE(PG8_SA(0, 1), a2 + hstep, voffA);
            PG8_WAIT_L(8); PG8_BAR; PG8_WAIT_L(0); PG8_MMA(0, 0, At, B0); PG8_BAR; PG8_SCHED;
            PG8_LDB(B1, 1, 1); PG8_STAGE(PG8_SB(1, 0), b3, voffB);
            PG8_BAR; PG8_WAIT_L(0); PG8_MMA(0, 1, At, B1); PG8_BAR;
            PG8_LDA(At, 1, 1); PG8_STAGE(PG8_SA(1, 0), a3, voffA);
            PG8_BAR; PG8_WAIT_L(0); PG8_MMA(1, 0, At, B0); PG8_BAR; PG8_SCHED;
            PG8_STAGE(PG8_SB(1, 1), b3 + hstep, voffB);
            PG8_WAIT_V(6); PG8_BAR; PG8_MMA(1, 1, At, B1); PG8_BAR;
            }
        }
        if constexpr (ALIGN_EPI) { if (wr == 0) PG8_BAR; }
        if constexpr (!Epi::AFTER_DRAIN) { const int l2 = fresh_lane(); E(acc, cur, wr, wc, l2 & 15, l2 >> 4); S.done(cur); }
        if (!has_next) break;
#pragma unroll
        for (int a = 0; a < 2; ++a)
#pragma unroll
            for (int b = 0; b < 2; ++b)
#pragma unroll
                for (int m = 0; m < 4; ++m)
#pragma unroll
                    for (int n = 0; n < 2; ++n) acc[a][b][m][n] = (f32x4){0.f, 0.f, 0.f, 0.f};
        cur = nxt; cA = nA; cB = nB; ++ui;
        if constexpr (ALIGN_EPI) { if (wr == 1) PG8_BAR; }
    }
    PG8_WAIT_V(0);
    if constexpr (!ALIGN_EPI) { if (wr == 0) PG8_BAR; }
    PG8_BAR;
    if constexpr (Epi::AFTER_DRAIN) { E.fused(acc, cur, wr, wc, fr, fq, lds, wid, lane); S.done(cur); }
#undef PG8_SA
#undef PG8_SB
#undef PG8_STAGE
#undef PG8_LDA
#undef PG8_LDB
#undef PG8_MMA
#undef PG8_WAIT_V
#undef PG8_WAIT_L
#undef PG8_BAR
#undef PG8_SCHED
}
}

constexpr int NB = 4, SEQ = 2048, D = 2048, M = NB * SEQ, DEPTH = 4, PLE = 256, FF = 5632, NQKV = 18432;
constexpr int NWAVES = 8, NTHR = 512;
constexpr size_t MiB = 1ull << 20;
constexpr size_t WS_CTL = 0, CTL_ZERO_BYTES = 1 * MiB;
constexpr size_t WS_WQKV = 1 * MiB;
constexpr size_t WS_WAO = 145 * MiB;
constexpr size_t WS_WR1 = 161 * MiB;
constexpr size_t WS_WR2 = 188 * MiB;
constexpr size_t WS_WRO = 191 * MiB;
constexpr size_t WS_WCIN = 199 * MiB;
constexpr size_t WS_WCOUT = 223 * MiB;
constexpr size_t WS_WGU = 231 * MiB;
constexpr size_t WS_WDN = 407 * MiB;
constexpr size_t WS_WPG = 495 * MiB;
constexpr size_t WS_WPP = 527 * MiB;
constexpr size_t WS_XB = 531 * MiB;
constexpr size_t WS_SSQ = 595 * MiB;
constexpr size_t WS_PB = 597 * MiB;
constexpr size_t WS_PPO = 613 * MiB;
constexpr size_t WS_MO = 741 * MiB;
constexpr size_t WS_SCR = 773 * MiB;
constexpr size_t WS_END = 1233 * MiB;
constexpr size_t SC_QKV = 0, SC_O12 = 288 * MiB, SC_LSE = 352 * MiB;
constexpr size_t SC_GU = 0, SC_ACT = 176 * MiB, SC_GH = 0, SC_OWN = 2 * MiB;
constexpr size_t SC_MIX = 0, SC_WAG = 0, SC_RKV = 192 * MiB, SC_T1 = 384 * MiB, SC_Y = 396 * MiB;
constexpr size_t SC_BCU = 0;
constexpr int CW_BAR = 4096;

constexpr int RING_BYTES = 131072, MISC_OFF = RING_BYTES + 320, HALO_OFF = RING_BYTES + 2048  , LDS_BYTES = 147456;

#define GAS __attribute__((address_space(1)))
#define LAS __attribute__((address_space(3)))
typedef unsigned short bf16;
typedef unsigned v4u __attribute__((ext_vector_type(4)));
typedef unsigned v2u __attribute__((ext_vector_type(2)));
typedef float f32x4 __attribute__((ext_vector_type(4)));
typedef float f32x16 __attribute__((ext_vector_type(16)));
typedef short bf16x8 __attribute__((ext_vector_type(8)));
typedef short s16x4 __attribute__((ext_vector_type(4)));
#define LDS_WAIT() asm volatile("s_waitcnt lgkmcnt(0)" ::: "memory")
__device__ __forceinline__ unsigned f2bf(float f) { unsigned u = __builtin_bit_cast(unsigned, f); return (u + 0x7fffu + ((u >> 16) & 1u)) >> 16; }
__device__ __forceinline__ unsigned pk2(float lo, float hi) { return f2bf(lo) | (f2bf(hi) << 16); }
__device__ __forceinline__ float bfl(unsigned w) { return __uint_as_float(w << 16); }
__device__ __forceinline__ float bfh(unsigned w) { return __uint_as_float(w & 0xffff0000u); }
__device__ __forceinline__ float wave_sum(float v) {
#pragma unroll
    for (int o = 1; o < 64; o <<= 1) v += __shfl_xor(v, o);
    return v;
}
template <int CTRL> __device__ __forceinline__ float dpp_f(float x) { return __int_as_float(__builtin_amdgcn_update_dpp(0, __float_as_int(x), CTRL, 0xF, 0xF, true)); }
__device__ __forceinline__ float red8(float x) { x += dpp_f<0xB1>(x); x += dpp_f<0x4E>(x); x += dpp_f<0x141>(x); return x; }
__device__ __forceinline__ float red16(float x) { x = red8(x); x += dpp_f<0x140>(x); return x; }

#define XB_TMO      128
#define XB_XCNT(j)  (256  + 64 * (j))
#define XB_XSUB(j)  (1280 + 64 * (j))
#define XB_XGEN(j)  (2304 + 64 * (j))
#define XB_TOP      3328
#define XB_TOPGEN   3392
#define XCD_BAR_WORDS 3456
#define XB_SPIN_CAP (1u << 18)

__device__ __forceinline__ unsigned xb_ld(unsigned* p)              { return __hip_atomic_load(p, __ATOMIC_RELAXED, __HIP_MEMORY_SCOPE_AGENT); }
__device__ __forceinline__ unsigned xb_add(unsigned* p, unsigned v) { return __hip_atomic_fetch_add(p, v, __ATOMIC_RELAXED, __HIP_MEMORY_SCOPE_AGENT); }
__device__ __forceinline__ unsigned xb_xcc_id() { return (unsigned)__builtin_amdgcn_s_getreg((3 << 11) | 20) & 0xFu; }
#define XB_SPIN(cond, bar) do { unsigned _sp = 0; while (cond) { __builtin_amdgcn_s_sleep(1); \
    if ((++_sp & 255u) == 0u) { if (xb_ld(&(bar)[XB_TMO])) break; if (_sp > XB_SPIN_CAP) { atomicAdd(&(bar)[XB_TMO], 1u); break; } } } } while (0)

struct XcdBarrier {
    unsigned* bar; unsigned x;
    volatile LAS unsigned* st;
};

__device__ __forceinline__ XcdBarrier xcd_barrier_post(unsigned* bar, volatile LAS unsigned* st) {
    XcdBarrier b; b.bar = bar; b.x = xb_xcc_id(); b.st = st;
    if (threadIdx.x == 0) (void)xb_add(&bar[XB_XCNT(b.x)], 1u);
    return b;
}
__device__ __forceinline__ void xcd_barrier_complete(unsigned* bar, unsigned x, unsigned& nloc, unsigned& nx) {
    const unsigned G = gridDim.x * gridDim.y * gridDim.z;
    unsigned sum, cnt, mine, sp = 0u;
    for (;;) {
        sum = 0u; cnt = 0u; mine = 0u;
#pragma unroll
        for (unsigned j = 0; j < 16; ++j) { const unsigned c = xb_ld(&bar[XB_XCNT(j)]); sum += c; cnt += (c > 0u) ? 1u : 0u; mine = (j == x) ? c : mine; }
        if (sum == G) break;
        __builtin_amdgcn_s_sleep(1);
        if ((++sp & 255u) == 0u) { if (xb_ld(&bar[XB_TMO])) break; if (sp > XB_SPIN_CAP) { atomicAdd(&bar[XB_TMO], 1u); break; } }
    }
    nloc = mine > 0u ? mine : 1u; nx = cnt > 0u ? cnt : 1u;
}

__device__ __forceinline__ void xcd_barrier(const XcdBarrier& b) {
    asm volatile("s_waitcnt vmcnt(0)" ::: "memory");
    __syncthreads();
    if (threadIdx.x == 0) {
        unsigned* bar = b.bar;
        __builtin_amdgcn_s_waitcnt(0);
        unsigned nloc = b.st[0], nx = b.st[1];
        if (nloc == 0u) { xcd_barrier_complete(bar, b.x, nloc, nx); b.st[0] = nloc; b.st[1] = nx; }
        const unsigned old = xb_add(&bar[XB_XSUB(b.x)], 1u);
        const unsigned gen = old / nloc;
        if (old + 1u == (gen + 1u) * nloc) {
            __builtin_amdgcn_fence(__ATOMIC_RELEASE, "agent");
            asm volatile("s_waitcnt vmcnt(0)" ::: "memory");
            const unsigned og = xb_add(&bar[XB_TOP], 1u);
            const unsigned tg = og / nx;
            if (og + 1u == (tg + 1u) * nx) xb_add(&bar[XB_TOPGEN], 1u);
            else XB_SPIN(xb_ld(&bar[XB_TOPGEN]) == tg, bar);
            __builtin_amdgcn_fence(__ATOMIC_ACQUIRE, "agent");
            xb_add(&bar[XB_XGEN(b.x)], 1u);
            asm volatile("s_waitcnt vmcnt(0)" ::: "memory");
        } else {
            XB_SPIN(xb_ld(&bar[XB_XGEN(b.x)]) == gen, bar);
            __builtin_amdgcn_fence(__ATOMIC_ACQUIRE, "agent");
            asm volatile("s_waitcnt vmcnt(0)" ::: "memory");
        }
    }
    __syncthreads();
}


struct Params { const float* in[35]; float* out; unsigned char* wsp; int lo, hi; };
struct Frame {
    LAS unsigned char* lds;
    int tid, lane;
    int wave;
    int vcu, G;
    __device__ __forceinline__ void ids() { lane = fresh_lane(); tid = wave * 64 + lane; }
};
constexpr int PTR_OFF = RING_BYTES + 1024;
__device__ __forceinline__ const float* in_ptr(const Frame& F, int idx) {
    const LAS unsigned* p = (const LAS unsigned*)(F.lds + PTR_OFF) + 2 * idx; const unsigned lo = __builtin_amdgcn_readfirstlane(p[0]), hi = __builtin_amdgcn_readfirstlane(p[1]);
    return (const float*)(const GAS float*)(size_t)(((unsigned long long)hi << 32) | lo); }
#define T_OUT 35
#define T_WS 36
enum { I_X = 0, I_P, I_ATTN_NORM, I_ATTN_WQKV, I_ATTN_WO, I_RWKV_NORM, I_RWKV_MU, I_RWKV_WRKV, I_RWKV_W0, I_RWKV_WW1, I_RWKV_WW2, I_RWKV_A0, I_RWKV_WA1, I_RWKV_WA2, I_RWKV_WG1, I_RWKV_WG2,
       I_RWKV_KK, I_RWKV_KA, I_RWKV_RK, I_RWKV_LNG, I_RWKV_LNB, I_RWKV_WO, I_CONV_NORM, I_CONV_WIN, I_CONV_W, I_CONV_WOUT, I_FFN_NORM, I_FFN_WGU, I_FFN_CONVW, I_FFN_CONVB, I_FFN_WDOWN,
       I_PLE_WPROJ, I_PLE_NORM, I_PLE_WGATE, I_FINAL_NORM };

struct MatI { int in_idx; long long src_off; int gain_idx; int gain_off; long long dst_off; int K, N, Kp, Np; int ilv; };
#define MAT(ii, so, gi, go, dof, K_, N_, Kp_, Np_) { ii, (long long)(so), gi, go, (long long)(dof), K_, N_, Kp_, Np_, 0 }
#define MATI(ii, so, gi, go, dof, K_, N_, Kp_, Np_, il) { ii, (long long)(so), gi, go, (long long)(dof), K_, N_, Kp_, Np_, il }
__device__ const MatI kMats[] = {
    MAT(I_ATTN_WQKV, 0, I_ATTN_NORM, 0, WS_WQKV, D, NQKV, D, NQKV),
    MAT(I_ATTN_WO, 0, -1, 0, WS_WAO, D, D, D, D),
    MAT(I_RWKV_WRKV, 0, -1, 0, WS_WR1, D, D, D, D),
    MAT(I_RWKV_WRKV, (long long)D * D, -1, 0, WS_WR1 + (size_t)2048 * D * 2, D, D, D, D),
    MAT(I_RWKV_WRKV, 2ll * D * D, -1, 0, WS_WR1 + (size_t)4096 * D * 2, D, D, D, D),
    MAT(I_RWKV_WW1, 0, -1, 0, WS_WR1 + (size_t)6144 * D * 2, D, 96, D, 256),
    MAT(I_RWKV_WA1, 0, -1, 0, WS_WR1 + (size_t)6400 * D * 2, D, 96, D, 256),
    MAT(I_RWKV_WG1, 0, -1, 0, WS_WR1 + (size_t)6656 * D * 2, D, 256, D, 256),
    MAT(I_RWKV_WW2, 0, -1, 0, WS_WR2, 96, D, 256, D),
    MAT(I_RWKV_WA2, 0, -1, 0, WS_WR2 + (size_t)2048 * 256 * 2, 96, D, 256, D),
    MAT(I_RWKV_WG2, 0, -1, 0, WS_WR2 + (size_t)4096 * 256 * 2, 256, D, 256, D),
    MAT(I_RWKV_WO, 0, -1, 0, WS_WRO, D, D, D, D),
    MATI(I_FFN_WGU, 0ll * D * 2 * FF, I_FFN_NORM, 0 * D, WS_WGU + 0 * 44 * MiB, D, 2 * FF, D, 2 * FF, FF),
    MATI(I_FFN_WGU, 1ll * D * 2 * FF, I_FFN_NORM, 1 * D, WS_WGU + 1 * 44 * MiB, D, 2 * FF, D, 2 * FF, FF),
    MAT(I_FFN_WDOWN, 0ll * FF * D, -1, 0, WS_WDN + 0 * 22 * MiB, FF, D, FF, D),
    MAT(I_FFN_WDOWN, 1ll * FF * D, -1, 0, WS_WDN + 1 * 22 * MiB, FF, D, FF, D),
    MAT(I_PLE_WGATE, 0ll * D * D, I_PLE_NORM, 0 * D, WS_WPG + 0 * 8 * MiB, D, D, D, D),
    MAT(I_PLE_WGATE, 1ll * D * D, I_PLE_NORM, 1 * D, WS_WPG + 1 * 8 * MiB, D, D, D, D),
    MAT(I_PLE_WPROJ, 0ll * PLE * D, -1, 0, WS_WPP + 0 * MiB, PLE, D, PLE, D),
    MAT(I_PLE_WPROJ, 1ll * PLE * D, -1, 0, WS_WPP + 1 * MiB, PLE, D, PLE, D),
    MAT(I_PLE_WPROJ, 2ll * PLE * D, -1, 0, WS_WPP + 2 * MiB, PLE, D, PLE, D),
    MAT(I_PLE_WPROJ, 3ll * PLE * D, -1, 0, WS_WPP + 3 * MiB, PLE, D, PLE, D),
    MAT(I_CONV_WIN, 0, I_CONV_NORM, 0, WS_WCIN, D, 3 * D, D, 3 * D),
    MAT(I_CONV_WOUT, 0, -1, 0, WS_WCOUT, D, D, D, D),
    MATI(I_FFN_WGU, 2ll * D * 2 * FF, I_FFN_NORM, 2 * D, WS_WGU + 2 * 44 * MiB, D, 2 * FF, D, 2 * FF, FF),
    MAT(I_FFN_WDOWN, 2ll * FF * D, -1, 0, WS_WDN + 2 * 22 * MiB, FF, D, FF, D),
    MAT(I_PLE_WGATE, 2ll * D * D, I_PLE_NORM, 2 * D, WS_WPG + 2 * 8 * MiB, D, D, D, D),
    MAT(I_ATTN_WQKV, (long long)D * NQKV, I_ATTN_NORM, D, WS_WQKV + 72 * MiB, D, NQKV, D, NQKV),
    MAT(I_ATTN_WO, (long long)D * D, -1, 0, WS_WAO + 8 * MiB, D, D, D, D),
    MATI(I_FFN_WGU, 3ll * D * 2 * FF, I_FFN_NORM, 3 * D, WS_WGU + 3 * 44 * MiB, D, 2 * FF, D, 2 * FF, FF),
    MAT(I_FFN_WDOWN, 3ll * FF * D, -1, 0, WS_WDN + 3 * 22 * MiB, FF, D, FF, D),
    MAT(I_PLE_WGATE, 3ll * D * D, I_PLE_NORM, 3 * D, WS_WPG + 3 * 8 * MiB, D, D, D, D),
};
constexpr int NMAT = sizeof(kMats) / sizeof(kMats[0]);
static_assert(NMAT == 32, "matrix groups A [0,22) B [22,27) C [27,29) D [29,32)");

__device__ __forceinline__ void conv_item(const float* W, const float* gain, int K, int N, int Kp, int Np, int ilv, bf16* WT, LAS float* scr, int item, int lane) {
    const int nblk = Np / 64, kb = item / nblk, nb = item % nblk, k0 = 64 * kb, n0 = 64 * nb;
    const int d0 = ilv ? (((n0 % ilv) >> 7) * 256 + (n0 / ilv) * 128 + ((n0 % ilv) & 127)) : n0;
    const int kr = lane >> 3, n4 = lane & 7;
    f32x4 v[2][8];
#pragma unroll
    for (int hf = 0; hf < 2; ++hf)
#pragma unroll
        for (int i = 0; i < 8; ++i) { const int k = k0 + 8 * i + kr, n = n0 + 32 * hf + 4 * n4;
            v[hf][i] = (k < K && n < N) ? *(const GAS f32x4*)(W + (size_t)k * N + n) : (f32x4){0.f, 0.f, 0.f, 0.f}; }
    if (gain) {
#pragma unroll
        for (int i = 0; i < 8; ++i) { const int k = k0 + 8 * i + kr; const float g = k < K ? gain[k] : 0.f; v[0][i] *= g; v[1][i] *= g; } }
    const int c = lane & 7;
#pragma unroll
    for (int hf = 0; hf < 2; ++hf) {
#pragma unroll
        for (int i = 0; i < 8; ++i) { LAS float* d = scr + (8 * i + kr) * 33 + 4 * n4; d[0] = v[hf][i][0]; d[1] = v[hf][i][1]; d[2] = v[hf][i][2]; d[3] = v[hf][i][3]; }
        LDS_WAIT(); asm volatile("" ::: "memory");
#pragma unroll
        for (int j = 0; j < 4; ++j) { const int nn = (lane >> 3) + 8 * j; const LAS float* sp = scr + (8 * c) * 33 + nn;
            v4u o; o.x = pk2(sp[0 * 33], sp[1 * 33]); o.y = pk2(sp[2 * 33], sp[3 * 33]); o.z = pk2(sp[4 * 33], sp[5 * 33]); o.w = pk2(sp[6 * 33], sp[7 * 33]);
            *(GAS v4u*)(WT + (size_t)(d0 + 32 * hf + nn) * Kp + k0 + 8 * c) = o; }
        LDS_WAIT(); asm volatile("" ::: "memory");
    }
}

__device__ __forceinline__ void convert_mats(Frame& F, int m_lo, int m_hi, int gw, int NGW) {
    LAS float* scr = (LAS float*)(F.lds + F.wave * 16384);
    int it = gw, base = 0;
    for (int mi = m_lo; mi < m_hi; ++mi) {
        const MatI mt = kMats[mi]; const int cnt = (mt.Kp / 64) * (mt.Np / 64);
        const float* src = in_ptr(F, mt.in_idx) + mt.src_off; const float* gain = mt.gain_idx >= 0 ? in_ptr(F, mt.gain_idx) + mt.gain_off : nullptr; bf16* dst = (bf16*)((unsigned char*)in_ptr(F, T_WS) + mt.dst_off);
        while (it < base + cnt) { conv_item(src, gain, mt.K, mt.N, mt.Kp, mt.Np, mt.ilv, dst, scr, it - base, F.lane); it += NGW; }
        base += cnt;
    }
}
__device__ __forceinline__ void p_prologue(Frame& F) {
    F.ids();
    unsigned char* const ws_ = (unsigned char*)in_ptr(F, T_WS);
    const int gw = F.vcu * NWAVES + F.wave, NGW = F.G * NWAVES;
    convert_mats(F, 0, 22, gw, NGW);
    const float* x = in_ptr(F, I_X); bf16* xb = (bf16*)(ws_ + WS_XB); float* ssq = (float*)(ws_ + WS_SSQ);
    for (int m = gw; m < M; m += NGW) {
        const GAS f32x4* xr = (const GAS f32x4*)(x + (size_t)m * D) + F.lane; GAS v2u* o8 = (GAS v2u*)(xb + (size_t)m * D) + F.lane; float s = 0.f;
#pragma unroll
        for (int j = 0; j < 8; ++j) { const f32x4 v = xr[64 * j]; s += (v[0] * v[0] + v[1] * v[1]) + (v[2] * v[2] + v[3] * v[3]); v2u w; w.x = pk2(v[0], v[1]); w.y = pk2(v[2], v[3]); o8[64 * j] = w; }
        s = wave_sum(s);
        if (F.lane < 32) ssq[(size_t)m * 32 + F.lane] = F.lane == 0 ? s : 0.f;
    }
    const GAS f32x4* p4 = (const GAS f32x4*)in_ptr(F, I_P); GAS v2u* pb = (GAS v2u*)(ws_ + WS_PB);
    for (size_t i = (size_t)F.vcu * NTHR + F.tid; i < (size_t)DEPTH * M * PLE / 4; i += (size_t)F.G * NTHR) { const f32x4 v = p4[i]; v2u w; w.x = pk2(v[0], v[1]); w.y = pk2(v[2], v[3]); pb[i] = w; }
}

__device__ __forceinline__ int tokrow(int b, int v, int Lsh) { return b * SEQ + ((v & ((1 << Lsh) - 1)) << (11 - Lsh)) + (v >> Lsh); }
template <int OFF> __device__ __forceinline__ s16x4 tr_read(unsigned a) { s16x4 r; asm volatile("ds_read_b64_tr_b16 %0, %1 offset:%2" : "=&v"(r) : "v"(a), "i"(OFF) : "memory"); return r; }
constexpr int VROW = 320;

template <bool COMBINE>
__device__ __forceinline__ void attn_phase(Frame& F, const bf16* QKV, bf16* O12, float* LSE, bf16* MO) {
    F.ids();
    const unsigned ldsb = (unsigned)(size_t)F.lds;
    const int nunits = COMBINE ? NB * 16 * 8 : NB * 2 * 16 * 8;
    for (int u = F.vcu; u < nunits; u += F.G) {
        F.ids();
        const int lane = F.lane, ql = lane & 31, hh = lane >> 5;
        const int qblk = u & 7, h = (u >> 3) & 15, rest = u >> 7;
        const int gg = COMBINE ? 0 : 1 + (rest & 1), b = COMBINE ? rest : (rest >> 1);
        const int Lsh = gg == 0 ? 11 : (gg == 1 ? 9 : 7);
        const int q0 = qblk * 256, cs0 = (q0 >> Lsh) << Lsh, kv0 = (q0 - 128) > cs0 ? (q0 - 128) : cs0;
        const bf16* Qp = QKV + (size_t)gg * 6144 + h * 128; const bf16* Kp = Qp + 2048; const bf16* Vp = Qp + 4096;
        __syncthreads();
        for (int i = F.tid; i < (q0 + 256 - kv0) * 16; i += NTHR) { const int v = kv0 + (i >> 4), ch = i & 15;
            const v4u val = *(const GAS v4u*)(Vp + (size_t)tokrow(b, v, Lsh) * NQKV + ch * 8);
            *(LAS v4u*)(F.lds + (v - (q0 - 128)) * VROW + ch * 16) = val; }
        __syncthreads();
        const int qw0 = q0 + 32 * F.wave, cs = (qw0 >> Lsh) << Lsh;
        const int qrow = tokrow(b, qw0 + ql, Lsh);
        bf16x8 qf[8];
#pragma unroll
        for (int s = 0; s < 8; ++s) qf[s] = *(const GAS bf16x8*)(Qp + (size_t)qrow * NQKV + 16 * s + 8 * hh);
        f32x16 S[5];
#define LOADK(dst, kb_) do { const int ks_ = qw0 - 128 + 32 * (kb_); if (ks_ >= cs) { const bf16* kp_ = Kp + (size_t)tokrow(b, ks_ + ql, Lsh) * NQKV + 8 * hh; \
        _Pragma("unroll") for (int s_ = 0; s_ < 8; ++s_) dst[s_] = *(const GAS bf16x8*)(kp_ + 16 * s_); } } while (0)
#define QKBLK(kf_, kb_) do { _Pragma("unroll") for (int r_ = 0; r_ < 16; ++r_) S[kb_][r_] = 0.f; \
        if ((qw0 - 128 + 32 * (kb_)) >= cs) { _Pragma("unroll") for (int s_ = 0; s_ < 8; ++s_) S[kb_] = __builtin_amdgcn_mfma_f32_32x32x16_bf16(kf_[s_], qf[s_], S[kb_], 0, 0, 0); } \
        __builtin_amdgcn_sched_barrier(0); } while (0)
        {
            bf16x8 ka[8], kbf[8];
#pragma unroll
            for (int s_ = 0; s_ < 8; ++s_) { ka[s_] = (bf16x8){0, 0, 0, 0, 0, 0, 0, 0}; kbf[s_] = ka[s_]; }
            LOADK(ka, 0); __builtin_amdgcn_sched_barrier(0);
            LOADK(kbf, 1); QKBLK(ka, 0);
            LOADK(ka, 2); QKBLK(kbf, 1);
            LOADK(kbf, 3); QKBLK(ka, 2);
            LOADK(ka, 4); QKBLK(kbf, 3);
            QKBLK(ka, 4);
        }
#undef LOADK
#undef QKBLK
        const float c1 = 0.08838834764831845f * 1.4426950408889634f;
        const float sl2 = exp2f(-8.0f * (float)(gg * 16 + h + 1) / 48.0f) * (float)(1 << (11 - Lsh)) * 1.4426950408889634f;
        const float lb = -sl2 * (float)(ql - 4 * hh);
        float mx = -3.0e38f;
#pragma unroll
        for (int kb = 0; kb < 5; ++kb) { const bool live = (qw0 - 128 + 32 * kb) >= cs;
#pragma unroll
            for (int r = 0; r < 16; ++r) { const int cr = (r & 3) + 8 * (r >> 2);
                float sc = S[kb][r] * c1 + (sl2 * (float)(cr - 128 + 32 * kb) + lb);
                if (kb == 0) sc = (cr + 4 * hh >= ql) ? sc : -1.0e30f;
                if (kb == 4) sc = (cr + 4 * hh <= ql) ? sc : -1.0e30f;
                sc = live ? sc : -1.0e30f;
                S[kb][r] = sc; mx = fmaxf(mx, sc); } }
        mx = fmaxf(mx, __shfl_xor(mx, 32));
        float l = 0.f;
#pragma unroll
        for (int kb = 0; kb < 5; ++kb)
#pragma unroll
            for (int r = 0; r < 16; ++r) { const float p = __builtin_amdgcn_exp2f(S[kb][r] - mx); S[kb][r] = p; l += p; }
        l += __shfl_xor(l, 32);
        f32x16 o[4];
#pragma unroll
        for (int c = 0; c < 4; ++c)
#pragma unroll
            for (int r = 0; r < 16; ++r) o[c][r] = 0.f;
        const unsigned va0 = ldsb + (unsigned)((4 * hh + ((lane & 15) >> 2)) * VROW + (16 * ((lane >> 4) & 1) + 4 * (lane & 3)) * 2);
#pragma unroll
        for (int kb = 0; kb < 5; ++kb) {
            if ((qw0 - 128 + 32 * kb) >= cs) {
#pragma unroll
                for (int s = 0; s < 2; ++s) {
                    const unsigned va = va0 + (unsigned)((32 * F.wave + 32 * kb + 16 * s) * VROW);
                    const s16x4 l0 = tr_read<0>(va), h0 = tr_read<8 * VROW>(va), l1 = tr_read<64>(va), h1 = tr_read<64 + 8 * VROW>(va);
                    const s16x4 l2 = tr_read<128>(va), h2 = tr_read<128 + 8 * VROW>(va), l3 = tr_read<192>(va), h3 = tr_read<192 + 8 * VROW>(va);
                    v4u pw; pw.x = pg8::cvt_pk_bf16(S[kb][8 * s + 0], S[kb][8 * s + 1]); pw.y = pg8::cvt_pk_bf16(S[kb][8 * s + 2], S[kb][8 * s + 3]);
                    pw.z = pg8::cvt_pk_bf16(S[kb][8 * s + 4], S[kb][8 * s + 5]); pw.w = pg8::cvt_pk_bf16(S[kb][8 * s + 6], S[kb][8 * s + 7]);
                    const bf16x8 pb = __builtin_bit_cast(bf16x8, pw);
                    asm volatile("s_waitcnt lgkmcnt(0)" ::: "memory"); __builtin_amdgcn_sched_barrier(0);
#define PKV(L, H) (bf16x8){L[0], L[1], L[2], L[3], H[0], H[1], H[2], H[3]}
                    o[0] = __builtin_amdgcn_mfma_f32_32x32x16_bf16(PKV(l0, h0), pb, o[0], 0, 0, 0);
                    o[1] = __builtin_amdgcn_mfma_f32_32x32x16_bf16(PKV(l1, h1), pb, o[1], 0, 0, 0);
                    o[2] = __builtin_amdgcn_mfma_f32_32x32x16_bf16(PKV(l2, h2), pb, o[2], 0, 0, 0);
                    o[3] = __builtin_amdgcn_mfma_f32_32x32x16_bf16(PKV(l3, h3), pb, o[3], 0, 0, 0);
#undef PKV
                }
            }
        }
        const float inv = 1.0f / l, lse0 = mx + __builtin_amdgcn_logf(l);
        if (!COMBINE) {
            bf16* orow = O12 + (size_t)(gg - 1) * M * D + (size_t)qrow * D + h * 128 + 4 * hh;
#pragma unroll
            for (int c = 0; c < 4; ++c)
#pragma unroll
                for (int g4 = 0; g4 < 4; ++g4) { v2u w; w.x = pg8::cvt_pk_bf16(o[c][4 * g4] * inv, o[c][4 * g4 + 1] * inv); w.y = pg8::cvt_pk_bf16(o[c][4 * g4 + 2] * inv, o[c][4 * g4 + 3] * inv);
                    *(GAS v2u*)(orow + 32 * c + 8 * g4) = w; }
            if (hh == 0) LSE[(size_t)(gg - 1) * M * 16 + (size_t)qrow * 16 + h] = lse0;
        } else {
            const float l1 = LSE[(size_t)qrow * 16 + h], l2 = LSE[(size_t)M * 16 + (size_t)qrow * 16 + h];
            const float mm = fmaxf(lse0, fmaxf(l1, l2));
            const float e0 = __builtin_amdgcn_exp2f(lse0 - mm), e1 = __builtin_amdgcn_exp2f(l1 - mm), e2 = __builtin_amdgcn_exp2f(l2 - mm);
            const float rd = 1.0f / (e0 + e1 + e2), w0 = e0 * inv * rd, w1 = e1 * rd, w2 = e2 * rd;
            const bf16* o1p = O12 + (size_t)qrow * D + h * 128 + 4 * hh; const bf16* o2p = o1p + (size_t)M * D;
            bf16* orow = MO + (size_t)qrow * D + h * 128 + 4 * hh;
#pragma unroll
            for (int c = 0; c < 4; ++c)
#pragma unroll
                for (int g4 = 0; g4 < 4; ++g4) { const v2u a = *(const GAS v2u*)(o1p + 32 * c + 8 * g4), bq = *(const GAS v2u*)(o2p + 32 * c + 8 * g4);
                    const float r0 = w0 * o[c][4 * g4] + w1 * bfl(a.x) + w2 * bfl(bq.x), r1 = w0 * o[c][4 * g4 + 1] + w1 * bfh(a.x) + w2 * bfh(bq.x);
                    const float r2 = w0 * o[c][4 * g4 + 2] + w1 * bfl(a.y) + w2 * bfl(bq.y), r3 = w0 * o[c][4 * g4 + 3] + w1 * bfh(a.y) + w2 * bfh(bq.y);
                    v2u w; w.x = pg8::cvt_pk_bf16(r0, r1); w.y = pg8::cvt_pk_bf16(r2, r3); *(GAS v2u*)(orow + 32 * c + 8 * g4) = w; }
        }
    }
    __syncthreads();
}

__device__ __forceinline__ void unpack8(const v4u w, float (&f)[8]) { f[0] = bfl(w.x); f[1] = bfh(w.x); f[2] = bfl(w.y); f[3] = bfh(w.y); f[4] = bfl(w.z); f[5] = bfh(w.z); f[6] = bfl(w.w); f[7] = bfh(w.w); }
__device__ __forceinline__ v4u pack8(const float (&f)[8]) { v4u w; w.x = pk2(f[0], f[1]); w.y = pk2(f[2], f[3]); w.z = pk2(f[4], f[5]); w.w = pk2(f[6], f[7]); return w; }
__device__ __forceinline__ void ffn_act_phase(Frame& F, const bf16* GU, bf16* ACT, const float* cw, const float* cb) {
    F.ids();
    constexpr int C8 = FF / 8;
    const size_t total = (size_t)(M / 4) * C8;
    for (size_t i = (size_t)F.vcu * NTHR + F.tid; i < total; i += (size_t)F.G * NTHR) {
        const int rg = (int)(i / C8), c8 = (int)(i % C8), r0 = rg * 4, t0 = r0 & (SEQ - 1), c = c8 * 8;
        float w0[8], w1[8], w2[8], bb[8];
#pragma unroll
        for (int j = 0; j < 8; ++j) { w0[j] = cw[c + j]; w1[j] = cw[FF + c + j]; w2[j] = cw[2 * FF + c + j]; bb[j] = cb[c + j]; }
        float g[6][8];
#pragma unroll
        for (int k = 0; k < 6; ++k) { const int t = t0 - 2 + k;
            if (t >= 0) unpack8(*(const GAS v4u*)(GU + (size_t)(r0 - 2 + k) * (2 * FF) + c), g[k]);
            else {
#pragma unroll
                for (int j = 0; j < 8; ++j) g[k][j] = 0.f; } }
#pragma unroll
        for (int k = 0; k < 4; ++k) { float up[8], o[8]; unpack8(*(const GAS v4u*)(GU + (size_t)(r0 + k) * (2 * FF) + FF + c), up);
#pragma unroll
            for (int j = 0; j < 8; ++j) { const float z = w0[j] * g[k][j] + w1[j] * g[k + 1][j] + w2[j] * g[k + 2][j] + bb[j]; o[j] = z * pg8::fast_sigmoid(z) * up[j]; }
            *(GAS v4u*)(ACT + (size_t)(r0 + k) * FF + c) = pack8(o); }
    }
}
__device__ __forceinline__ void ffn_fixup(Frame& F, int pm, const float* GH, const float* OWN, bf16* ACT, const float* cw, const float* cb) {
    if ((pm & 7) == 0) return;
    for (int idx = F.tid; idx < 44 * 128; idx += NTHR) { const int pn = idx >> 7, c = idx & 127, ch = pn * 128 + c;
        const float* gh = GH + ((size_t)(pm - 1) * 44 + pn) * 256; const float* ow = OWN + ((size_t)pm * 44 + pn) * 512;
        const float gm2 = gh[c], gm1 = gh[128 + c], g0 = ow[c], u0 = ow[128 + c], g1 = ow[256 + c], u1 = ow[384 + c];
        const float w0 = cw[ch], w1 = cw[FF + ch], w2 = cw[2 * FF + ch], b = cb[ch];
        const float z0 = w0 * gm2 + w1 * gm1 + w2 * g0 + b, z1 = w0 * gm1 + w1 * g0 + w2 * g1 + b;
        ACT[(size_t)(pm * 256) * FF + ch] = (bf16)f2bf(z0 * pg8::fast_sigmoid(z0) * u0);
        ACT[(size_t)(pm * 256 + 1) * FF + ch] = (bf16)f2bf(z1 * pg8::fast_sigmoid(z1) * u1); }
    asm volatile("s_waitcnt vmcnt(0)" ::: "memory");
}
__device__ __forceinline__ void conv_mix_phase(Frame& F, const bf16* BCU, bf16* Z, const float* cw) {
    F.ids();
    constexpr int C8 = D / 8;
    const size_t total = (size_t)(M / 4) * C8;
    for (size_t i = (size_t)F.vcu * NTHR + F.tid; i < total; i += (size_t)F.G * NTHR) {
        const int rg = (int)(i / C8), c8 = (int)(i % C8), r0 = rg * 4, t0 = r0 & (SEQ - 1), c = c8 * 8;
        float w0[8], w1[8], w2[8];
#pragma unroll
        for (int j = 0; j < 8; ++j) { w0[j] = cw[c + j]; w1[j] = cw[D + c + j]; w2[j] = cw[2 * D + c + j]; }
        float cu[6][8];
#pragma unroll
        for (int k = 0; k < 6; ++k) { const int t = t0 - 2 + k;
            if (t >= 0) { float a[8], b2[8]; const bf16* rp = BCU + (size_t)(r0 - 2 + k) * (3 * D) + c; unpack8(*(const GAS v4u*)(rp + D), a); unpack8(*(const GAS v4u*)(rp + 2 * D), b2);
#pragma unroll
                for (int j = 0; j < 8; ++j) cu[k][j] = a[j] * b2[j]; }
            else {
#pragma unroll
                for (int j = 0; j < 8; ++j) cu[k][j] = 0.f; } }
#pragma unroll
        for (int k = 0; k < 4; ++k) { float gb[8], o[8]; unpack8(*(const GAS v4u*)(BCU + (size_t)(r0 + k) * (3 * D) + c), gb);
#pragma unroll
            for (int j = 0; j < 8; ++j) o[j] = gb[j] * (w0[j] * cu[k][j] + w1[j] * cu[k + 1][j] + w2[j] * cu[k + 2][j]);
            *(GAS v4u*)(Z + (size_t)(r0 + k) * D + c) = pack8(o); }
    }
}

__device__ __forceinline__ void rwkv_mix_phase(Frame& F, const float* X, const float* ssq, const float* gn, const float* mu, bf16* MIX) {
    F.ids();
    const int gw = F.vcu * NWAVES + F.wave, NGW = F.G * NWAVES, lane = F.lane;
    for (int m = gw; m < M; m += NGW) {
        const int t = m & (SEQ - 1);
        float s1 = lane < 32 ? ssq[(size_t)m * 32 + lane] : 0.f, s0 = (lane < 32 && t > 0) ? ssq[(size_t)(m - 1) * 32 + lane] : 0.f;
        s1 = wave_sum(s1); s0 = wave_sum(s0);
        const float r1 = __builtin_amdgcn_rsqf(s1 * (1.0f / D) + 1e-6f), r0 = t > 0 ? __builtin_amdgcn_rsqf(s0 * (1.0f / D) + 1e-6f) : 0.f;
        const GAS f32x4* x1 = (const GAS f32x4*)(X + (size_t)m * D) + lane; const GAS f32x4* x0 = (const GAS f32x4*)(X + (size_t)(t > 0 ? m - 1 : m) * D) + lane;
        const GAS f32x4* g4 = (const GAS f32x4*)gn + lane; const GAS f32x4* mu4 = (const GAS f32x4*)mu + lane;
#pragma unroll 2
        for (int j = 0; j < 8; ++j) { const f32x4 gv = g4[64 * j]; const f32x4 hv = x1[64 * j] * gv * r1, hp = x0[64 * j] * gv * r0, xx = hp - hv;
#pragma unroll
            for (int i = 0; i < 6; ++i) { const f32x4 o = hv + xx * mu4[i * (D / 4) + 64 * j]; v2u w; w.x = pk2(o[0], o[1]); w.y = pk2(o[2], o[3]);
                *((GAS v2u*)(MIX + (size_t)i * M * D + (size_t)m * D) + lane + 64 * j) = w; } }
    }
}

constexpr int SC_T = 32, SC_ARR = SC_T * 64 * 4, SC_BUF = 5 * SC_ARR + SC_T * 32 * 4, SC_YOFF = 2 * SC_BUF, SC_YB = SC_T * 32 * 4;
__device__ __forceinline__ void rwkv_scan_phase(Frame& F, const float* RKV, const float* WAG, const float* k_k, const float* k_a, float* Y) {
    F.ids();
    const int tid = F.tid, lane = F.lane, wave = F.wave;
    for (int item = F.vcu; item < NB * 32 * 2; item += F.G) {
        const int half = item & 1, h = (item >> 1) & 31, b = item >> 6;
        const size_t gbase = (size_t)b * SEQ * D + h * 64;
        __syncthreads();
        if (wave >= 4) {
            const int st = tid - 256, ts = st >> 4, c4 = st & 15;
            const f32x4 kkc = *(const GAS f32x4*)(k_k + h * 64 + 4 * c4), kac = *(const GAS f32x4*)(k_a + h * 64 + 4 * c4);
#define ST_LOAD(RG, chunk_) do { _Pragma("unroll") for (int ps = 0; ps < 2; ++ps) { const size_t go = gbase + (size_t)((chunk_) * SC_T + ts + 16 * ps) * D + 4 * c4; \
                RG[ps][0] = *(const GAS f32x4*)(RKV + go); RG[ps][1] = *(const GAS f32x4*)(RKV + (size_t)M * D + go); RG[ps][2] = *(const GAS f32x4*)(RKV + 2 * (size_t)M * D + go); \
                RG[ps][3] = *(const GAS f32x4*)(WAG + go); RG[ps][4] = *(const GAS f32x4*)(WAG + (size_t)M * D + go); } } while (0)
#define ST_PROC(RG, chunk_) do { LAS unsigned char* bp = F.lds + ((chunk_) & 1) * SC_BUF; _Pragma("unroll") for (int ps = 0; ps < 2; ++ps) { const int tt = ts + 16 * ps; \
                const f32x4 r4 = RG[ps][0], k4 = RG[ps][1], v4 = RG[ps][2], w4 = RG[ps][3], a4 = RG[ps][4]; \
                const f32x4 kr = k4 * kkc; float n2 = (kr[0] * kr[0] + kr[1] * kr[1]) + (kr[2] * kr[2] + kr[3] * kr[3]); n2 = red16(n2); \
                const float rn = 1.0f / fmaxf(sqrtf(n2), 1e-12f); const f32x4 kk = kr * rn; const f32x4 kn = k4 * (1.0f + (a4 - 1.0f) * kac); \
                const int lo = tt * 64 + 4 * c4; \
                *(LAS f32x4*)(bp + 0 * SC_ARR + lo * 4) = r4; *(LAS f32x4*)(bp + 1 * SC_ARR + lo * 4) = w4; *(LAS f32x4*)(bp + 2 * SC_ARR + lo * 4) = kn; \
                *(LAS f32x4*)(bp + 3 * SC_ARR + lo * 4) = -kk; *(LAS f32x4*)(bp + 4 * SC_ARR + lo * 4) = kk * a4; \
                if ((c4 >> 3) == half) *(LAS f32x4*)(bp + 5 * SC_ARR + (tt * 32 + 4 * (c4 & 7)) * 4) = v4; } } while (0)
#define ST_FLUSH(chunk_) do { const int t_ = st >> 3, v4_ = st & 7; const LAS float* yb_ = (const LAS float*)(F.lds + SC_YOFF + ((chunk_) & 1) * SC_YB); \
                *(GAS f32x4*)(Y + gbase + (size_t)((chunk_) * SC_T + t_) * D + 32 * half + 4 * v4_) = *(const LAS f32x4*)(yb_ + t_ * 32 + 4 * v4_); } while (0)
            constexpr int NCH = SEQ / SC_T;
            f32x4 RA[2][5], RB[2][5];
            ST_LOAD(RA, 0); ST_LOAD(RB, 1);
            ST_PROC(RA, 0);
            __syncthreads();
            for (int ci = 0; ci < NCH; ci += 2) {
                if (ci >= 1) ST_FLUSH(ci - 1);
                if (ci + 2 < NCH) ST_LOAD(RA, ci + 2);
                ST_PROC(RB, ci + 1);
                __syncthreads();
                ST_FLUSH(ci);
                if (ci + 3 < NCH) ST_LOAD(RB, ci + 3);
                if (ci + 2 < NCH) ST_PROC(RA, ci + 2);
                __syncthreads();
            }
            ST_FLUSH(NCH - 1);
#undef ST_LOAD
#undef ST_PROC
#undef ST_FLUSH
        } else {
            const int row = lane >> 3, kg = lane & 7, vr = 8 * wave + row;
            typedef float f32x2 __attribute__((ext_vector_type(2)));
            f32x2 s[4];
#pragma unroll
            for (int i = 0; i < 4; ++i) s[i] = (f32x2){0.f, 0.f};
            __syncthreads();
            for (int ci = 0; ci < SEQ / SC_T; ++ci) {
                const LAS unsigned char* bp = F.lds + (ci & 1) * SC_BUF; LAS float* yb = (LAS float*)(F.lds + SC_YOFF + (ci & 1) * SC_YB);
#define SC_LOAD(R_, W_, K_, A_, B_, V_, t_) do { const int lo_ = ((t_) * 64 + 8 * kg) * 4; \
                    const f32x4 ra_ = *(const LAS f32x4*)(bp + 0 * SC_ARR + lo_), rb_ = *(const LAS f32x4*)(bp + 0 * SC_ARR + lo_ + 16); \
                    const f32x4 wa_ = *(const LAS f32x4*)(bp + 1 * SC_ARR + lo_), wb_ = *(const LAS f32x4*)(bp + 1 * SC_ARR + lo_ + 16); \
                    const f32x4 ka_ = *(const LAS f32x4*)(bp + 2 * SC_ARR + lo_), kb_ = *(const LAS f32x4*)(bp + 2 * SC_ARR + lo_ + 16); \
                    const f32x4 aa_ = *(const LAS f32x4*)(bp + 3 * SC_ARR + lo_), ab_ = *(const LAS f32x4*)(bp + 3 * SC_ARR + lo_ + 16); \
                    const f32x4 ba_ = *(const LAS f32x4*)(bp + 4 * SC_ARR + lo_), bb_ = *(const LAS f32x4*)(bp + 4 * SC_ARR + lo_ + 16); \
                    V_ = *(const LAS float*)(bp + 5 * SC_ARR + ((t_) * 32 + vr) * 4); \
                    R_[0] = (f32x2){ra_[0], ra_[1]}; R_[1] = (f32x2){ra_[2], ra_[3]}; R_[2] = (f32x2){rb_[0], rb_[1]}; R_[3] = (f32x2){rb_[2], rb_[3]}; \
                    W_[0] = (f32x2){wa_[0], wa_[1]}; W_[1] = (f32x2){wa_[2], wa_[3]}; W_[2] = (f32x2){wb_[0], wb_[1]}; W_[3] = (f32x2){wb_[2], wb_[3]}; \
                    K_[0] = (f32x2){ka_[0], ka_[1]}; K_[1] = (f32x2){ka_[2], ka_[3]}; K_[2] = (f32x2){kb_[0], kb_[1]}; K_[3] = (f32x2){kb_[2], kb_[3]}; \
                    A_[0] = (f32x2){aa_[0], aa_[1]}; A_[1] = (f32x2){aa_[2], aa_[3]}; A_[2] = (f32x2){ab_[0], ab_[1]}; A_[3] = (f32x2){ab_[2], ab_[3]}; \
                    B_[0] = (f32x2){ba_[0], ba_[1]}; B_[1] = (f32x2){ba_[2], ba_[3]}; B_[2] = (f32x2){bb_[0], bb_[1]}; B_[3] = (f32x2){bb_[2], bb_[3]}; } while (0)
#define SC_STEP(R_, W_, K_, A_, B_, V_, t_) do { \
                    f32x2 q0_ = s[0] * A_[0], q1_ = s[1] * A_[1]; q0_ = s[2] * A_[2] + q0_; q1_ = s[3] * A_[3] + q1_; q0_ = q0_ + q1_; \
                    float sa_ = red8(q0_[0] + q0_[1]); \
                    const f32x2 vv_ = (f32x2){V_, V_}; \
                    f32x2 p0_ = s[0] * W_[0] + vv_ * K_[0], p1_ = s[1] * W_[1] + vv_ * K_[1], p2_ = s[2] * W_[2] + vv_ * K_[2], p3_ = s[3] * W_[3] + vv_ * K_[3]; \
                    const f32x2 sv_ = (f32x2){sa_, sa_}; \
                    s[0] = sv_ * B_[0] + p0_; s[1] = sv_ * B_[1] + p1_; s[2] = sv_ * B_[2] + p2_; s[3] = sv_ * B_[3] + p3_; \
                    f32x2 y0_ = s[0] * R_[0], y1_ = s[1] * R_[1]; y0_ = s[2] * R_[2] + y0_; y1_ = s[3] * R_[3] + y1_; y0_ = y0_ + y1_; \
                    const float y_ = red8(y0_[0] + y0_[1]); \
                    if (kg == 0) yb[(t_) * 32 + vr] = y_; } while (0)
                f32x2 r0[4], w0[4], k0[4], a0[4], b0[4], r1[4], w1[4], k1[4], a1[4], b1[4]; float v0, v1;
                SC_LOAD(r0, w0, k0, a0, b0, v0, 0);
#pragma unroll
                for (int t = 0; t < SC_T; t += 2) {
                    SC_LOAD(r1, w1, k1, a1, b1, v1, t + 1);
                    SC_STEP(r0, w0, k0, a0, b0, v0, t);
                    if (t + 2 < SC_T) SC_LOAD(r0, w0, k0, a0, b0, v0, t + 2);
                    SC_STEP(r1, w1, k1, a1, b1, v1, t + 1);
                }
#undef SC_LOAD
#undef SC_STEP
                __syncthreads();
            }
        }
    }
    __syncthreads();
}

__device__ __forceinline__ void rwkv_post_phase(Frame& F, const float* Y, const float* RKV, const float* WAG, const float* k_a, const float* r_k, const float* ln_g, const float* ln_b, bf16* MO) {
    F.ids();
    const int gw = F.vcu * NWAVES + F.wave, NGW = F.G * NWAVES, lane = F.lane;
    for (int it = gw; it < M * 32; it += NGW) {
        const int row = it >> 5, h = it & 31, c = h * 64 + lane; const size_t o = (size_t)row * D + c;
        const float y = Y[o], r = RKV[o], k = RKV[(size_t)M * D + o], v = RKV[2 * (size_t)M * D + o], a = WAG[(size_t)M * D + o], g = WAG[2 * (size_t)M * D + o];
        const float mean = wave_sum(y) * (1.0f / 64.0f), dy = y - mean, var = wave_sum(dy * dy) * (1.0f / 64.0f);
        const float yn = dy * __builtin_amdgcn_rsqf(var + 6.4e-4f) * ln_g[c] + ln_b[c];
        const float kn = k * (1.0f + (a - 1.0f) * k_a[c]);
        const float bonus = wave_sum(r * kn * r_k[c]) * v;
        MO[o] = (bf16)f2bf((yn + bonus) * g);
    }
}

__device__ __forceinline__ void final_norm_phase(Frame& F, float* X, const float* gn) {
    F.ids();
    const int gw = F.vcu * NWAVES + F.wave, NGW = F.G * NWAVES, lane = F.lane;
    for (int m = gw; m < M; m += NGW) {
        GAS f32x4* xr = (GAS f32x4*)(X + (size_t)m * D) + lane; const GAS f32x4* g4 = (const GAS f32x4*)gn + lane;
        f32x4 v[8]; float s = 0.f;
#pragma unroll
        for (int j = 0; j < 8; ++j) { v[j] = xr[64 * j]; s += (v[j][0] * v[j][0] + v[j][1] * v[j][1]) + (v[j][2] * v[j][2] + v[j][3] * v[j][3]); }
        const float rs = __builtin_amdgcn_rsqf(wave_sum(s) * (1.0f / D) + 1e-6f);
#pragma unroll
        for (int j = 0; j < 8; ++j) xr[64 * j] = v[j] * rs * g4[64 * j];
    }
}

constexpr int NPH = 43;
__host__ __device__ constexpr bool phase_used(int ph) {
    if (ph == 1) return false;
    if (ph < 2 || ph == NPH - 1) return true;
    const int L = (ph - 2) / 10, s = (ph - 2) % 10, kind = L % 3;
    if (s >= 6) return s != 7;
    return kind == 0 ? s < 4 : (kind == 1 ? true : s < 3);
}

#define IN(k) (lo <= (k) && (k) < hi)
#if MK_PER_PHASE
#define SEAM(k) do { } while (0)
#else
#define SEAM(k) do { if ((k) + 1 < hi) { XcdBarrier b_; b_.bar = (unsigned*)(ws + WS_CTL) + CW_BAR; b_.x = xb_xcc_id(); b_.st = (volatile LAS unsigned*)(F.lds + MISC_OFF) + 8; xcd_barrier(b_); } } while (0)
#endif
#define ws ((unsigned char*)in_ptr(F, T_WS))
#define XO ((float*)in_ptr(F, T_OUT))
#define INP(i) in_ptr(F, (i))
#define MO ((bf16*)(ws + WS_MO))
#define scr (ws + WS_SCR)
template <int L> __device__ __forceinline__ void layer_phases(Frame& F, const int lo, const int hi, const XcdBarrier& bar, const int bid) {
    constexpr int pb = 2 + 10 * L, kind = L % 3, j = L / 3, ver = 3 * L;
#define xcur ((L == 0) ? INP(I_X) : (const float*)XO)
#define XB0 ((bf16*)(ws + WS_XB))
#define SQ0 ((float*)(ws + WS_SSQ))
#define XBV(v) (XB0 + (size_t)((v) & 1) * M * D)
#define SQV(v) (SQ0 + (size_t)((v) & 1) * M * 32)
#define Wout ((const bf16*)(ws + (kind == 0 ? WS_WAO + (size_t)j * 8 * MiB : (kind == 1 ? WS_WRO : WS_WCOUT))))
    if constexpr (kind == 0) {
#define QKV ((bf16*)(scr + SC_QKV))
#define O12 ((bf16*)(scr + SC_O12))
#define LSE ((float*)(scr + SC_LSE))
        if (IN(pb + 0)) {
            pg8::Gemm g{XBV(ver), (const bf16*)(ws + WS_WQKV + (size_t)j * 72 * MiB), M, NQKV, D, 0, 1 << 30, 1 << 30};
            pg8::StaticOrder S; S.init(M, NQKV, F.G, bid);
            pg8::EpiScaleBf16<true> E{QKV, NQKV, SQV(ver), 0, 0};
            pg8::gemm_phase<pg8::EpiScaleBf16<true>, pg8::StaticOrder, true, true>(F.lds, g, S, E, F.wave);
            SEAM(pb + 0);
        }
        if (IN(pb + 1)) { attn_phase<false>(F, QKV, O12, LSE, MO); SEAM(pb + 1); }
        if (IN(pb + 2)) { attn_phase<true>(F, QKV, O12, LSE, MO); SEAM(pb + 2); }
    } else if constexpr (kind == 1) {
#define MIX ((bf16*)(scr + SC_MIX))
#define WAG ((float*)(scr + SC_WAG))
#define RKV ((float*)(scr + SC_RKV))
#define T1 ((bf16*)(scr + SC_T1))
#define YB ((float*)(scr + SC_Y))
        if (IN(pb + 0)) { rwkv_mix_phase(F, xcur, SQV(ver), INP(I_RWKV_NORM) + (size_t)j * D, INP(I_RWKV_MU) + (size_t)j * 6 * D, MIX); SEAM(pb + 0); }
        if (IN(pb + 1)) {
            pg8::Gemm g{MIX, (const bf16*)(ws + WS_WR1), M, 6912, D, (size_t)M * D * 2, 8, 24};
            pg8::StaticOrder S; S.init(M, 6912, F.G, bid);
            pg8::EpiR1 E{RKV, T1, M};
            pg8::gemm_phase<pg8::EpiR1, pg8::StaticOrder, true, true>(F.lds, g, S, E, F.wave);
            {
                const int rem = (M / 256) * (6912 / 256) % F.G, nidle = rem ? F.G - rem : 0, ci = bid - rem;
                F.ids();
                if (nidle > 0) { if (ci >= 0) convert_mats(F, 22, 27, ci * NWAVES + F.wave, nidle * NWAVES); }
                else convert_mats(F, 22, 27, bid * NWAVES + F.wave, F.G * NWAVES);
            }
            SEAM(pb + 1);
        }
        if (IN(pb + 2)) {
            pg8::Gemm g{T1, (const bf16*)(ws + WS_WR2), M, 3 * D, 256, (size_t)M * 256 * 2, 8, 1 << 30};
            pg8::StaticOrder S; S.init(M, 3 * D, F.G, bid);
            pg8::EpiR2 E{WAG, INP(I_RWKV_W0) + (size_t)j * D, INP(I_RWKV_A0) + (size_t)j * D, M};
            pg8::gemm_phase<pg8::EpiR2, pg8::StaticOrder, true, true>(F.lds, g, S, E, F.wave);
            SEAM(pb + 2);
        }
        if (IN(pb + 3)) { rwkv_scan_phase(F, RKV, WAG, INP(I_RWKV_KK) + (size_t)j * D, INP(I_RWKV_KA) + (size_t)j * D, YB); SEAM(pb + 3); }
        if (IN(pb + 4)) { rwkv_post_phase(F, YB, RKV, WAG, INP(I_RWKV_KA) + (size_t)j * D, INP(I_RWKV_RK) + (size_t)j * D, INP(I_RWKV_LNG) + (size_t)j * D, INP(I_RWKV_LNB) + (size_t)j * D, MO); SEAM(pb + 4); }
    } else {
#define BCU ((bf16*)(scr + SC_BCU))
        if (IN(pb + 0)) {
            pg8::Gemm g{XBV(ver), (const bf16*)(ws + WS_WCIN), M, 3 * D, D, 0, 1 << 30, 1 << 30};
            pg8::StaticOrder S; S.init(M, 3 * D, F.G, bid);
            pg8::EpiScaleBf16<true> E{BCU, 3 * D, SQV(ver), 0, 0};
            pg8::gemm_phase<pg8::EpiScaleBf16<true>, pg8::StaticOrder, true, true>(F.lds, g, S, E, F.wave);
            SEAM(pb + 0);
        }
        if (IN(pb + 1)) { conv_mix_phase(F, BCU, MO, INP(I_CONV_W) + (size_t)j * 3 * D); SEAM(pb + 1); }
    }
    constexpr int ps_out = pb + (kind == 0 ? 3 : (kind == 1 ? 5 : 2));
    if (IN(ps_out)) {
        pg8::Gemm g{MO, Wout, M, D, D, 0, 1 << 30, 1 << 30};
        pg8::StaticOrder S; S.init(M, D, F.G, bid);
        pg8::EpiResid E{xcur, XO, XBV(ver + 1), SQV(ver + 1)};
        pg8::gemm_phase<pg8::EpiResid, pg8::StaticOrder, true, true>(F.lds, g, S, E, F.wave);
        SEAM(ps_out);
    }
#define GU ((bf16*)(scr + SC_GU))
#define ACT ((bf16*)(scr + SC_ACT))
    if (IN(pb + 6)) {
        pg8::Gemm g{XBV(ver + 1), (const bf16*)(ws + WS_WGU + (size_t)L * 44 * MiB), M, 2 * FF, D, 0, 1 << 30, 1 << 30};
        pg8::StaticOrder S; S.init(M, 2 * FF, F.G, bid);
        pg8::EpiFfnAct E{ACT, SQV(ver + 1), INP(I_FFN_CONVW) + (size_t)L * 3 * FF, INP(I_FFN_CONVB) + (size_t)L * FF, (float*)(scr + SC_GH), (float*)(scr + SC_OWN), (LAS float*)(F.lds + HALO_OFF)};
        pg8::gemm_phase<pg8::EpiFfnAct, pg8::StaticOrder, true, true>(F.lds, g, S, E, F.wave);
        {
            const int rem = (M / 256) * (2 * FF / 256) % F.G, nidle = rem ? F.G - rem : 0, ci = bid - rem;
            if (nidle > 0 && ci >= 0) {
                if constexpr (L == 0) {
                    pg8::Gemm g2{(const bf16*)(ws + WS_PB), (const bf16*)(ws + WS_WPP), M, 4 * D, PLE, (size_t)M * PLE * 2, 8, 1 << 30};
                    pg8::StaticOrder S2; S2.init(M, 4 * D, nidle, ci);
                    pg8::EpiScaleBf16<false> E2{(bf16*)(ws + WS_PPO), D, nullptr, D, (size_t)M * D};
                    pg8::gemm_phase<pg8::EpiScaleBf16<false>, pg8::StaticOrder, true, true>(F.lds, g2, S2, E2, F.wave);
                } else if constexpr (L == 1) { F.ids(); convert_mats(F, 27, 29, ci * NWAVES + F.wave, nidle * NWAVES); }
                else if constexpr (L == 2) { F.ids(); convert_mats(F, 29, 32, ci * NWAVES + F.wave, nidle * NWAVES); }
            } else if (nidle == 0) {
                if constexpr (L == 0) {
                    pg8::Gemm g2{(const bf16*)(ws + WS_PB), (const bf16*)(ws + WS_WPP), M, 4 * D, PLE, (size_t)M * PLE * 2, 8, 1 << 30};
                    pg8::StaticOrder S2; S2.init(M, 4 * D, F.G, bid);
                    pg8::EpiScaleBf16<false> E2{(bf16*)(ws + WS_PPO), D, nullptr, D, (size_t)M * D};
                    pg8::gemm_phase<pg8::EpiScaleBf16<false>, pg8::StaticOrder, true, true>(F.lds, g2, S2, E2, F.wave);
                } else if constexpr (L == 1) { F.ids(); convert_mats(F, 27, 29, bid * NWAVES + F.wave, F.G * NWAVES); }
                else if constexpr (L == 2) { F.ids(); convert_mats(F, 29, 32, bid * NWAVES + F.wave, F.G * NWAVES); }
            }
        }
        SEAM(pb + 6);
    }
    if (IN(pb + 8)) {
        pg8::Gemm g{ACT, (const bf16*)(ws + WS_WDN + (size_t)L * 22 * MiB), M, D, FF, 0, 1 << 30, 1 << 30};
        pg8::StaticOrder S; S.init(M, D, F.G, bid);
        { pg8::Unit fu; F.ids(); for (int i = 0; S.next(i, fu); ++i) ffn_fixup(F, fu.pm, (const float*)(scr + SC_GH), (const float*)(scr + SC_OWN), ACT, INP(I_FFN_CONVW) + (size_t)L * 3 * FF, INP(I_FFN_CONVB) + (size_t)L * FF); __syncthreads(); }
        pg8::EpiResid E{XO, XO, XBV(ver + 2), SQV(ver + 2)};
        pg8::gemm_phase<pg8::EpiResid, pg8::StaticOrder, true, true>(F.lds, g, S, E, F.wave);
        SEAM(pb + 8);
    }
    if (IN(pb + 9)) {
        pg8::Gemm g{XBV(ver + 2), (const bf16*)(ws + WS_WPG + (size_t)L * 8 * MiB), M, D, D, 0, 1 << 30, 1 << 30};
        pg8::StaticOrder S; S.init(M, D, F.G, bid);
        pg8::EpiPle E{SQV(ver + 2), XO, (const bf16*)(ws + WS_PPO) + (size_t)L * M * D, XO, XBV(ver + 3), SQV(ver + 3)};
        pg8::gemm_phase<pg8::EpiPle, pg8::StaticOrder, true, true>(F.lds, g, S, E, F.wave);
        SEAM(pb + 9);
    }
}

__global__ void __launch_bounds__(NTHR, 2) mega_fwd(Params P) {
    extern __shared__ __attribute__((aligned(16))) unsigned char lds_raw[];
    Frame F;
    F.lds = (LAS unsigned char*)lds_raw;
    F.wave = __builtin_amdgcn_readfirstlane((int)threadIdx.x >> 6); F.ids();
    F.G = gridDim.x; { const int bx = blockIdx.x; F.vcu = (F.G % 8 == 0) ? (bx % 8) * (F.G / 8) + bx / 8 : bx; }
    volatile LAS unsigned* MISC = (volatile LAS unsigned*)(F.lds + MISC_OFF);
    for (int u = F.tid; u < (LDS_BYTES - RING_BYTES) / 4; u += NTHR) ((LAS unsigned*)(F.lds + RING_BYTES))[u] = 0u;
    __syncthreads();
    if (F.tid == 0) {
#pragma unroll
        for (int i = 0; i < 35; ++i) ((LAS unsigned long long*)(F.lds + PTR_OFF))[i] = (unsigned long long)(size_t)P.in[i];
        ((LAS unsigned long long*)(F.lds + PTR_OFF))[T_OUT] = (unsigned long long)(size_t)P.out; ((LAS unsigned long long*)(F.lds + PTR_OFF))[T_WS] = (unsigned long long)(size_t)P.wsp; }
    __syncthreads();
    XcdBarrier bar; bar.bar = nullptr; bar.x = 0; bar.st = nullptr;
#if !MK_PER_PHASE
    (void)xcd_barrier_post((unsigned*)(P.wsp + WS_CTL) + CW_BAR, MISC + 8);
#endif
    const int lo = P.lo, hi = P.hi;
    const int bid = (int)blockIdx.x;

    if (IN(0)) { p_prologue(F); SEAM(0); }
    layer_phases<0>(F, lo, hi, bar, bid);
    layer_phases<1>(F, lo, hi, bar, bid);
    layer_phases<2>(F, lo, hi, bar, bid);
    layer_phases<3>(F, lo, hi, bar, bid);
    if (IN(NPH - 1)) final_norm_phase(F, XO, INP(I_FINAL_NORM));
#undef IN
#undef SEAM
#undef ws
#undef XO
#undef INP
#undef MO
#undef scr
#undef xcur
#undef XB0
#undef SQ0
#undef Wout
#undef QKV
#undef O12
#undef LSE
#undef MIX
#undef WAG
#undef RKV
#undef T1
#undef YB
#undef BCU
#undef GU
#undef ACT
#undef XBV
#undef SQV
}

extern "C" void kernel_launch(void* const* d_in, const int* in_sizes, int n_in, void* d_out, int out_size, void* d_ws, size_t ws_size, hipStream_t stream) {
    static int grid = 0;
    if (grid == 0) {
        if (n_in != 35 || out_size != M * D || ws_size < WS_END) { fprintf(stderr, "kernel_launch: unexpected problem: n_in %d out %d ws %zu (need %zu)\n", n_in, out_size, ws_size, (size_t)WS_END); grid = -1; return; }
        int dev = 0, cus = 0, per_cu = 0;
        if (hipGetDevice(&dev) != hipSuccess || hipDeviceGetAttribute(&cus, hipDeviceAttributeMultiprocessorCount, dev) != hipSuccess) { grid = -1; return; }
        if (hipFuncSetAttribute((const void*)mega_fwd, hipFuncAttributeMaxDynamicSharedMemorySize, LDS_BYTES) != hipSuccess) { fprintf(stderr, "kernel_launch: hipFuncSetAttribute failed\n"); grid = -1; return; }
        if (hipOccupancyMaxActiveBlocksPerMultiprocessor(&per_cu, (const void*)mega_fwd, NTHR, LDS_BYTES) != hipSuccess || per_cu < 1) fprintf(stderr, "kernel_launch: occupancy query says %d blocks per CU\n", per_cu);
        (void)hipGetLastError();
        grid = cus;
    }
    if (grid < 0) return;
    if (hipMemsetAsync((char*)d_ws + WS_CTL, 0, CTL_ZERO_BYTES, stream) != hipSuccess) return;
    Params a{};
    for (int i = 0; i < 35; ++i) a.in[i] = (const float*)d_in[i];
    a.out = (float*)d_out; a.wsp = (unsigned char*)d_ws;
#if MK_PER_PHASE
    for (int ph = 0; ph < NPH; ++ph) { if (!phase_used(ph)) continue; a.lo = ph; a.hi = ph + 1;
        for (int rep = 0; rep < ((ph == PROBE_PH || ph == PROBE_PH2) ? 1 + PROBE_REPS : 1); ++rep) hipLaunchKernelGGL(mega_fwd, dim3(grid), dim3(NTHR), LDS_BYTES, stream, a); }
#else
    a.lo = 0; a.hi = NPH; hipLaunchKernelGGL(mega_fwd, dim3(grid), dim3(NTHR), LDS_BYTES, stream, a);
#endif
}
```
